# Optimizing an MI355X kernel written in HIP

```python
import math
import jax
import jax.numpy as jnp
from jax import lax
import numpy as np

D_MODEL = 1024
BATCH = 2
SEQ = 16384
DEPTH = 2

GRID_W = 64
CTX_LEN = 256
Q_BLOCK = 128
ROPE_THETA = 10000.0
NORM_EPS = 1e-6
ALPHA = (2 * DEPTH) ** 0.25
BETA = (8 * DEPTH) ** -0.25
N_EVEN = (DEPTH + 1) // 2
N_ODD = DEPTH // 2
HEAD_DIM = 64
A_Q_HEADS = 12
A_KV_HEADS = 4
POOL_WINDOWS = (2, 4, 8, 16)
POOL_GROUP = 64
POOL_WIDTH = POOL_GROUP * len(POOL_WINDOWS)
C_HEADS = 8
C_Q_RANK = 384
C_KV_RANK = 256
C_NOPE = 64
C_ROPE = 32
C_V = 64
D_HEADS = 8
NA_WIN_H = 8
NA_WIN_W = 16
D_FF = 2816
N_EXPERTS = 8
TOP_K = 2
D_FF_EXPERT = 3584
MOE_BLOCK = 256

A_Q_W = A_Q_HEADS * HEAD_DIM
A_KV_W = A_KV_HEADS * HEAD_DIM
EVEN_IN = A_Q_W + 2 * A_KV_W + POOL_WIDTH
EVEN_MIX = A_Q_W + POOL_WIDTH
EVEN_SPLITS = (A_Q_W, A_Q_W + A_KV_W, A_Q_W + 2 * A_KV_W)
NA_W = D_HEADS * HEAD_DIM
ODD_IN = C_Q_RANK + C_KV_RANK + C_ROPE + 3 * NA_W
ODD_MIX = C_HEADS * C_V + NA_W
ODD_SPLITS = (C_Q_RANK, C_Q_RANK + C_KV_RANK, C_Q_RANK + C_KV_RANK + C_ROPE,
              C_Q_RANK + C_KV_RANK + C_ROPE + NA_W, C_Q_RANK + C_KV_RANK + C_ROPE + 2 * NA_W)

kernel_name = 'hybrid_flow_backbone'


def rms_norm(x, g):
    xf = x.astype(jnp.float32)
    y = xf * lax.rsqrt(jnp.mean(xf * xf, axis=-1, keepdims=True) + NORM_EPS)
    return (y * g.astype(jnp.float32)).astype(x.dtype)


def layer_norm(x, g, b):
    xf = x.astype(jnp.float32)
    mu = jnp.mean(xf, axis=-1, keepdims=True)
    var = jnp.mean(jnp.square(xf - mu), axis=-1, keepdims=True)
    y = (xf - mu) * lax.rsqrt(var + NORM_EPS)
    return (y * g.astype(jnp.float32) + b.astype(jnp.float32)).astype(x.dtype)


def modulate(x, shift, scale):
    return x * (1 + scale) + shift


def grid_positions(length):
    t = jnp.arange(length, dtype=jnp.int32)
    return (t // GRID_W).astype(jnp.float32), (t % GRID_W).astype(jnp.float32)


def rope_axis(x, pos):
    half = x.shape[-1] // 2
    inv = ROPE_THETA ** (-jnp.arange(half, dtype=jnp.float32) / half)
    ang = pos[:, None] * inv[None, :]
    cos = jnp.cos(ang)[None, :, None, :]
    sin = jnp.sin(ang)[None, :, None, :]
    x1, x2 = x[..., :half], x[..., half:]
    return jnp.concatenate([x1 * cos - x2 * sin, x1 * sin + x2 * cos], axis=-1).astype(x.dtype)


def rope_2d(x, row, col):
    n = x.shape[-1] // 2
    return jnp.concatenate([rope_axis(x[..., :n], row), rope_axis(x[..., n:], col)], axis=-1)


def block_attention(q, k, v):
    b, l, hq, dk = q.shape
    hkv, dv = k.shape[2], v.shape[-1]
    g = hq // hkv
    nb = l // Q_BLOCK
    scale = dk ** -0.5
    qb = q.reshape(b, nb, Q_BLOCK, hkv, g, dk).transpose(1, 0, 2, 3, 4, 5)

    def one(q_blk):
        s = jnp.einsum('bqhgd,bkhd->bhgqk', q_blk, k, preferred_element_type=jnp.float32) * scale
        p = jax.nn.softmax(s, axis=-1).astype(v.dtype)
        return jnp.einsum('bhgqk,bkhd->bqhgd', p, v)

    o = lax.map(one, qb)
    return o.transpose(1, 0, 2, 3, 4, 5).reshape(b, l, hq * dv)


def multiscale_pool(x, w_pool, pool_scale):
    b, l, _ = x.shape
    ng = len(POOL_WINDOWS)
    xg = x.reshape(b, l, ng, POOL_GROUP).astype(jnp.float32)
    csum = jnp.concatenate([jnp.zeros((b, 1, ng, POOL_GROUP), jnp.float32), jnp.cumsum(xg, axis=1)], axis=1)
    win = jnp.array(POOL_WINDOWS, dtype=jnp.int32)
    lo = win // 2
    hi = win - lo
    t = jnp.arange(l, dtype=jnp.int32)[:, None]
    start = jnp.clip(t - lo[None, :], 0, l)
    end = jnp.clip(t + hi[None, :], 0, l)
    gidx = jnp.arange(ng)[None, :]
    mean = (csum[:, end, gidx] - csum[:, start, gidx]) / (end - start).astype(jnp.float32)[None, :, :, None]
    y = (mean - xg).astype(x.dtype)
    y = jnp.einsum('blgc,gcd->blgd', y, w_pool).reshape(b, l, POOL_WIDTH)
    return y * pool_scale


def neighborhood_attention(q, k, v, k_ctx, v_ctx, rel_bias):
    b, l, h, d = q.shape
    rows = l // GRID_W
    kh = min(NA_WIN_H, rows)
    kw = NA_WIN_W
    scale = d ** -0.5
    qg = q.reshape(b, rows, GRID_W, h, d).transpose(1, 0, 2, 3, 4)
    kg = k.reshape(b, rows, GRID_W, h, d)
    vg = v.reshape(b, rows, GRID_W, h, d)
    j = jnp.arange(GRID_W, dtype=jnp.int32)
    col_start = jnp.clip(j - kw // 2, 0, GRID_W - kw)
    col_valid = (j[None, :] >= col_start[:, None]) & (j[None, :] < col_start[:, None] + kw)
    col_idx = jnp.clip(j[None, :] - j[:, None] + NA_WIN_W - 1, 0, 2 * NA_WIN_W - 2)

    def one_row(args):
        q_row, r = args
        rs = jnp.clip(r - kh // 2, 0, rows - kh)
        k_band = lax.dynamic_slice_in_dim(kg, rs, kh, axis=1)
        v_band = lax.dynamic_slice_in_dim(vg, rs, kh, axis=1)
        row_idx = rs + jnp.arange(kh, dtype=jnp.int32) - r + NA_WIN_H - 1
        bias = rel_bias[:, row_idx[:, None, None], col_idx[None, :, :]]
        s = jnp.einsum('bqhd,bikhd->bhqik', q_row, k_band, preferred_element_type=jnp.float32) * scale
        s = s + bias.transpose(0, 2, 1, 3)[None].astype(jnp.float32)
        s = jnp.where(col_valid[None, None, :, None, :], s, -jnp.inf)
        s_ctx = jnp.einsum('bqhd,bkhd->bhqk', q_row, k_ctx, preferred_element_type=jnp.float32) * scale
        p = jax.nn.softmax(jnp.concatenate([s.reshape(b, h, GRID_W, kh * GRID_W), s_ctx], axis=-1), axis=-1)
        p = p.astype(v.dtype)
        p_win = p[..., :kh * GRID_W].reshape(b, h, GRID_W, kh, GRID_W)
        p_ctx = p[..., kh * GRID_W:]
        return (jnp.einsum('bhqik,bikhd->bqhd', p_win, v_band)
                + jnp.einsum('bhqk,bkhd->bqhd', p_ctx, v_ctx))

    o = lax.map(one_row, (qg, jnp.arange(rows, dtype=jnp.int32)))
    return o.transpose(1, 0, 2, 3, 4).reshape(b, l, h * d)


def swiglu(u, w_gate, w_up, w_down):
    return (jax.nn.silu(u @ w_gate) * (u @ w_up)) @ w_down


def moe_swiglu(u, w_router, b_router, w_gate, w_up, w_down):
    shp = u.shape
    x = u.reshape(-1, shp[-1])
    t = x.shape[0]
    logits = jnp.dot(x, w_router, preferred_element_type=jnp.float32) + b_router.astype(jnp.float32)
    top_val, top_idx = lax.top_k(logits, TOP_K)
    gates = jax.nn.softmax(top_val, axis=-1)
    n_assign = t * TOP_K
    e_flat = top_idx.reshape(-1)
    order = jnp.argsort(e_flat)
    e_sorted = e_flat[order]
    tok_sorted = order // TOP_K
    g_sorted = gates.reshape(-1)[order]
    counts = jnp.bincount(e_flat, length=N_EXPERTS)
    padded = (counts + MOE_BLOCK - 1) // MOE_BLOCK * MOE_BLOCK
    start = jnp.cumsum(counts) - counts
    pad_end = jnp.cumsum(padded)
    pad_start = pad_end - padded
    dest = pad_start[e_sorted] + jnp.arange(n_assign, dtype=jnp.int32) - start[e_sorted]
    n_blocks = -(-n_assign // MOE_BLOCK) + N_EXPERTS
    x_pad = jnp.zeros((n_blocks * MOE_BLOCK, shp[-1]), x.dtype).at[dest].set(x[tok_sorted])
    blk_expert = jnp.minimum(
        jnp.searchsorted(pad_end, jnp.arange(n_blocks, dtype=jnp.int32) * MOE_BLOCK, side='right'),
        N_EXPERTS - 1)

    def one_block(args):
        xb, e = args
        return swiglu(xb, w_gate[e], w_up[e], w_down[e])

    y_pad = lax.map(one_block, (x_pad.reshape(n_blocks, MOE_BLOCK, shp[-1]), blk_expert))
    y_pad = y_pad.reshape(n_blocks * MOE_BLOCK, shp[-1])
    y = jnp.zeros_like(x).at[tok_sorted].add(y_pad[dest] * g_sorted[:, None].astype(x.dtype))
    return y.reshape(shp)


def even_mixer(u, u_ctx, w_in, w_out, q_gain, k_gain, w_pool, pool_scale, row, col, need_ctx):
    def project(h):
        b, l, _ = h.shape
        q, k, v, p = jnp.split(h, EVEN_SPLITS, axis=-1)
        q = rms_norm(q.reshape(b, l, A_Q_HEADS, HEAD_DIM), q_gain)
        k = rms_norm(k.reshape(b, l, A_KV_HEADS, HEAD_DIM), k_gain)
        return q, k, v.reshape(b, l, A_KV_HEADS, HEAD_DIM), p

    q, k, v, p = project(u @ w_in)
    qc, kc, vc, pc = project(u_ctx @ w_in)
    q = rope_2d(q, row, col)
    k = rope_2d(k, row, col)
    attn = block_attention(q, jnp.concatenate([kc, k], axis=1), jnp.concatenate([vc, v], axis=1))
    y = jnp.concatenate([attn, multiscale_pool(p, w_pool, pool_scale)], axis=-1) @ w_out
    y_ctx = None
    if need_ctx:
        attn_c = block_attention(qc, kc, vc)
        y_ctx = jnp.concatenate([attn_c, multiscale_pool(pc, w_pool, pool_scale)], axis=-1) @ w_out
    return y, y_ctx


def odd_mixer(u, u_ctx, w_in, w_out, q_lat_gain, kv_lat_gain, w_q_up, w_kv_up, na_bias, row, col, need_ctx):
    def project(h, rotate):
        b, l, _ = h.shape
        cq, ckv, kr, nq, nk, nv = jnp.split(h, ODD_SPLITS, axis=-1)
        q = (rms_norm(cq, q_lat_gain) @ w_q_up).reshape(b, l, C_HEADS, C_NOPE + C_ROPE)
        kv = (rms_norm(ckv, kv_lat_gain) @ w_kv_up).reshape(b, l, C_HEADS, C_NOPE + C_V)
        q_nope, q_rope = q[..., :C_NOPE], q[..., C_NOPE:]
        k_nope, v = kv[..., :C_NOPE], kv[..., C_NOPE:]
        kr = kr.reshape(b, l, 1, C_ROPE)
        if rotate:
            q_rope = rope_2d(q_rope, row, col)
            kr = rope_2d(kr, row, col)
        q = jnp.concatenate([q_nope, q_rope], axis=-1)
        k = jnp.concatenate([k_nope, jnp.broadcast_to(kr, (b, l, C_HEADS, C_ROPE))], axis=-1)
        shape_na = (b, l, D_HEADS, HEAD_DIM)
        return q, k, v, nq.reshape(shape_na), nk.reshape(shape_na), nv.reshape(shape_na)

    q, k, v, nq, nk, nv = project(u @ w_in, True)
    qc, kc, vc, nqc, nkc, nvc = project(u_ctx @ w_in, False)
    mla = block_attention(q, jnp.concatenate([kc, k], axis=1), jnp.concatenate([vc, v], axis=1))
    na = neighborhood_attention(nq, nk, nv, nkc, nvc, na_bias)
    y = jnp.concatenate([mla, na], axis=-1) @ w_out
    y_ctx = None
    if need_ctx:
        y_ctx = jnp.concatenate([block_attention(qc, kc, vc), block_attention(nqc, nkc, nvc)], axis=-1) @ w_out
    return y, y_ctx


def setup_inputs(seed: int = 0) -> dict:
    key = jax.random.key(seed)
    ks = iter(jax.random.split(key, 48))
    f32 = jnp.float32

    def nrm(shape, fan_in, s=1.0):
        return jax.random.normal(next(ks), shape, f32) * (s * fan_in ** -0.5)

    def gain(shape):
        return 1.0 + 0.05 * jax.random.normal(next(ks), shape, f32)

    def small(shape, s):
        return s * jax.random.normal(next(ks), shape, f32)

    d = D_MODEL
    return {
        'x': jax.random.normal(next(ks), (BATCH, SEQ, d), f32),
        'c': jax.random.normal(next(ks), (BATCH, d), f32),
        'ctx': jax.random.normal(next(ks), (BATCH, CTX_LEN, d), f32),
        'c_ctx': jax.random.normal(next(ks), (d,), f32),
        'w_ada': nrm((DEPTH, d, 6 * d), d, 0.5),
        'b_ada': small((DEPTH, 6 * d), 0.02),
        'ln1_g': gain((DEPTH, d)),
        'ln1_b': small((DEPTH, d), 0.02),
        'ln2_g': gain((DEPTH, d)),
        'ln2_b': small((DEPTH, d), 0.02),
        'ev_w_in': nrm((N_EVEN, d, EVEN_IN), d),
        'ev_w_out': nrm((N_EVEN, EVEN_MIX, d), EVEN_MIX, BETA),
        'ev_q_gain': gain((N_EVEN, HEAD_DIM)),
        'ev_k_gain': gain((N_EVEN, HEAD_DIM)),
        'ev_w_pool': nrm((N_EVEN, len(POOL_WINDOWS), POOL_GROUP, POOL_GROUP), POOL_GROUP),
        'ev_pool_scale': gain((N_EVEN, POOL_WIDTH)),
        'ev_w_gate': nrm((N_EVEN, d, D_FF), d),
        'ev_w_up': nrm((N_EVEN, d, D_FF), d),
        'ev_w_down': nrm((N_EVEN, D_FF, d), D_FF, BETA),
        'od_w_in': nrm((N_ODD, d, ODD_IN), d),
        'od_w_out': nrm((N_ODD, ODD_MIX, d), ODD_MIX, BETA),
        'od_q_lat_gain': gain((N_ODD, C_Q_RANK)),
        'od_kv_lat_gain': gain((N_ODD, C_KV_RANK)),
        'od_w_q_up': nrm((N_ODD, C_Q_RANK, C_HEADS * (C_NOPE + C_ROPE)), C_Q_RANK),
        'od_w_kv_up': nrm((N_ODD, C_KV_RANK, C_HEADS * (C_NOPE + C_V)), C_KV_RANK),
        'od_na_bias': small((N_ODD, D_HEADS, 2 * NA_WIN_H - 1, 2 * NA_WIN_W - 1), 0.2),
        'od_w_router': nrm((N_ODD, d, N_EXPERTS), d),
        'od_b_router': small((N_ODD, N_EXPERTS), 0.01),
        'od_w_gate': nrm((N_ODD, N_EXPERTS, d, D_FF_EXPERT), d),
        'od_w_up': nrm((N_ODD, N_EXPERTS, d, D_FF_EXPERT), d),
        'od_w_down': nrm((N_ODD, N_EXPERTS, D_FF_EXPERT, d), D_FF_EXPERT, BETA),
    }


def reference(x, c, ctx, c_ctx, w_ada, b_ada, ln1_g, ln1_b, ln2_g, ln2_b,
              ev_w_in, ev_w_out, ev_q_gain, ev_k_gain, ev_w_pool, ev_pool_scale,
              ev_w_gate, ev_w_up, ev_w_down,
              od_w_in, od_w_out, od_q_lat_gain, od_kv_lat_gain, od_w_q_up, od_w_kv_up, od_na_bias,
              od_w_router, od_b_router, od_w_gate, od_w_up, od_w_down):
    row, col = grid_positions(x.shape[1])
    silu_c = jax.nn.silu(c)
    silu_cc = jax.nn.silu(c_ctx)
    x_ctx = ctx
    for l in range(DEPTH):
        need_ctx = l < DEPTH - 1
        i = l // 2
        mod = jnp.split((silu_c @ w_ada[l] + b_ada[l])[:, None, :], 6, axis=-1)
        mod_c = jnp.split((silu_cc @ w_ada[l] + b_ada[l])[None, None, :], 6, axis=-1)
        u = modulate(x, mod[0], mod[1])
        u_c = modulate(x_ctx, mod_c[0], mod_c[1])
        if l % 2 == 0:
            y, y_c = even_mixer(u, u_c, ev_w_in[i], ev_w_out[i], ev_q_gain[i], ev_k_gain[i],
                                ev_w_pool[i], ev_pool_scale[i], row, col, need_ctx)
            ffn = lambda h, i=i: swiglu(h, ev_w_gate[i], ev_w_up[i], ev_w_down[i])
        else:
            y, y_c = odd_mixer(u, u_c, od_w_in[i], od_w_out[i], od_q_lat_gain[i], od_kv_lat_gain[i],
                               od_w_q_up[i], od_w_kv_up[i], od_na_bias[i], row, col, need_ctx)
            ffn = lambda h, i=i: moe_swiglu(h, od_w_router[i], od_b_router[i],
                                            od_w_gate[i], od_w_up[i], od_w_down[i])
        x = layer_norm(ALPHA * x + mod[2] * y, ln1_g[l], ln1_b[l])
        x = layer_norm(ALPHA * x + mod[5] * ffn(modulate(x, mod[3], mod[4])), ln2_g[l], ln2_b[l])
        if need_ctx:
            x_ctx = layer_norm(ALPHA * x_ctx + mod_c[2] * y_c, ln1_g[l], ln1_b[l])
            x_ctx = layer_norm(ALPHA * x_ctx + mod_c[5] * ffn(modulate(x_ctx, mod_c[3], mod_c[4])),
                               ln2_g[l], ln2_b[l])
    return x
```

```cpp
#include <hip/hip_runtime.h>
#include <cstdio>
#include <cstdint>

#ifndef MK_PER_PHASE
#define MK_PER_PHASE 0
#endif
#ifndef REP_A0
#define REP_A0 1
#endif
#ifndef REP_A1
#define REP_A1 1
#endif
#ifndef REP_NA
#define REP_NA 1
#endif
#ifndef REP_POOL
#define REP_POOL 1
#endif
#ifndef REP_P3
#define REP_P3 1
#endif
#ifndef REP_UP
#define REP_UP 1
#endif
#ifndef REP_DOWN
#define REP_DOWN 1
#endif
#ifndef REP_G
#define REP_G 1
#endif
#ifndef PROBE_K
#define PROBE_K 0
#endif

#define LAS __attribute__((address_space(3)))
#define GAS __attribute__((address_space(1)))
typedef unsigned short bf16;
typedef short bf16x8 __attribute__((ext_vector_type(8)));
typedef short v4i16_t __attribute__((ext_vector_type(4)));
typedef float f32x4 __attribute__((ext_vector_type(4)));
typedef float f32x2 __attribute__((ext_vector_type(2)));
typedef float f32x16 __attribute__((ext_vector_type(16)));
typedef unsigned u32x4 __attribute__((ext_vector_type(4)));
typedef unsigned u32x2 __attribute__((ext_vector_type(2)));
typedef GAS unsigned gu32;
#define RLX_AGENT __ATOMIC_RELAXED, __HIP_MEMORY_SCOPE_AGENT
#define LDS_WAIT() asm volatile("s_waitcnt lgkmcnt(0)" ::: "memory")
#define VM_WAIT() asm volatile("s_waitcnt vmcnt(0)" ::: "memory")

constexpr int DM = 1024, SEQ = 16384, MS = 32768, MC = 512, MA = MS + MC, CTX = 256, NKEY = CTX + SEQ;
constexpr int FF0 = 2816, FFE = 3584, NEXP = 8;
constexpr int N_IN0 = 1536, N_IN1 = 2304;
constexpr int C1_CQ = 0, C1_CKV = 384, C1_NQ = 640, C1_NK = 1152, C1_NV = 1664, C1_KR = 2176;
constexpr float LOG2E = 1.4426950408889634f;
constexpr float SC64 = 0.125f * LOG2E;
constexpr float SC96 = 0.10206207261596577f * LOG2E;
constexpr float ALPHA = 1.4142135623730951f;
constexpr float EPS = 1e-6f;
constexpr int MOE_TILES = 264, MOE_CHUNK_TILES = 128, MOE_CHUNKS = 3;

__device__ __forceinline__ float bf2f(unsigned short h) { return __uint_as_float((unsigned)h << 16); }
__device__ __forceinline__ unsigned f2bf(float f) { unsigned u = __float_as_uint(f); return (u + 0x7fffu + ((u >> 16) & 1u)) >> 16; }
__device__ __forceinline__ unsigned pk2(float lo, float hi) { return f2bf(lo) | (f2bf(hi) << 16); }
__device__ __forceinline__ unsigned cvt_pk_bf16(float lo, float hi) { unsigned r; asm volatile("v_cvt_pk_bf16_f32 %0, %1, %2" : "=v"(r) : "v"(lo), "v"(hi)); return r; }
__device__ __forceinline__ int lane_id() { int l; asm volatile("v_mbcnt_lo_u32_b32 %0, -1, 0\n\tv_mbcnt_hi_u32_b32 %0, -1, %0" : "=v"(l)); return l; }
__device__ __forceinline__ float shx(float v, int o) { const int l = lane_id(); return __uint_as_float((unsigned)__builtin_amdgcn_ds_bpermute((l ^ o) << 2, (int)__float_as_uint(v))); }
__device__ __forceinline__ float wave_max(float v) {
#pragma unroll
    for (int o = 1; o < 64; o <<= 1) v = fmaxf(v, shx(v, o));
    return v;
}
__device__ __forceinline__ float wave_sum(float v) {
#pragma unroll
    for (int o = 1; o < 64; o <<= 1) v += shx(v, o);
    return v;
}
__device__ __forceinline__ int kvrow(int m) {
    if (m < MS) { const int b = m >> 14, t = m & (SEQ - 1); return b * NKEY + CTX + t; }
    const int r = m - MS; return (r >> 8) * NKEY + (r & 255);
}

namespace pg8 {
constexpr int BM = 256, BK = 64, HALF = 128, HTB = HALF * BK * 2, STAGE_BYTES = 8 * HTB, NXCD = 8, WGM = 8;
__host__ __device__ __forceinline__ int lds_byte(int r, int c) { const int st = (r >> 4) * 2 + (c >> 5), rr = r & 15, cc = c & 31, ob = rr * 64 + cc * 2; return st * 1024 + (ob ^ (((ob >> 9) & 1) << 5)); }
__host__ __device__ __forceinline__ void stage_rc(int b, int& R, int& C) { const int st = b / 1024, sb = b % 1024, swz = sb ^ (((sb >> 9) & 1) << 5); R = (st >> 1) * 16 + swz / 64; C = (st & 1) * 32 + (swz % 64) / 2; }
__host__ __device__ __forceinline__ int perm32(int rho) { const int n = rho >> 4, i = rho & 15; return 8 * (i >> 2) + 4 * n + (i & 3); }

struct Unit { int pm, pn, e; };
struct Gemm { const void* A; const void* Bt; int K; int lda; size_t estride;
    const float* qa; const float* qw; int qwstride; };
typedef int i32x4v __attribute__((ext_vector_type(4))); typedef int i32x8v __attribute__((ext_vector_type(8)));
struct Frag2 { bf16x8 k[2]; };
template <int MODE> struct FragT { typedef Frag2 A; };
template <> struct FragT<1> { typedef i32x8v A; };

struct StaticOrder {
    int nM, nN, nwg, G, c;
    __device__ void init(int nM_, int nN_, int G_, int c_) { nM = nM_; nN = nN_; nwg = nM * nN; G = G_; c = c_; }
    __device__ bool next(int i, Unit& u) const {
        const long L = (long)i * G + c; if (L >= nwg) return false;
        int wgid = (int)L; { const int q = nwg / NXCD, r = nwg % NXCD, xcd = wgid % NXCD, off = wgid / NXCD; wgid = (xcd < r ? xcd * (q + 1) : r * (q + 1) + (xcd - r) * q) + off; }
        const int nig = WGM * nN, gid = wgid / nig, fm = gid * WGM, gsz = (nM - fm) < WGM ? (nM - fm) : WGM;
        u.pm = fm + ((wgid % nig) % gsz); u.pn = (wgid % nig) / gsz; u.e = 0; return true;
    }
};
struct MoeOrder {
    StaticOrder S; int tile0; int ts1, ts2, ts3, ts4, ts5, ts6, ts7;
    __device__ bool next(int i, Unit& u) const {
        if (!S.next(i, u)) return false;
        const int g = tile0 + u.pm;
        u.e = (g >= ts1) + (g >= ts2) + (g >= ts3) + (g >= ts4) + (g >= ts5) + (g >= ts6) + (g >= ts7);
        return true;
    }
};

struct EpiPlain {
    static constexpr bool PERM = true;
    bf16* O; int ldc;
    __device__ __forceinline__ void operator()(const f32x4 (&acc)[2][2][4][2], const Unit& u, int wr, int wc, int fr, int fq) const {
        const int row0 = u.pm * BM + wr * 64 + fr, col0 = u.pn * BM + wc * 32 + 8 * fq;
#pragma unroll
        for (int ai = 0; ai < 2; ++ai)
#pragma unroll
            for (int m = 0; m < 4; ++m) { bf16* rowp = O + (size_t)(row0 + ai * HALF + m * 16) * ldc + col0;
#pragma unroll
                for (int bj = 0; bj < 2; ++bj) { const f32x4 v0 = acc[ai][bj][m][0], v1 = acc[ai][bj][m][1];
                    u32x4 w; w.x = cvt_pk_bf16(v0[0], v0[1]); w.y = cvt_pk_bf16(v0[2], v0[3]); w.z = cvt_pk_bf16(v1[0], v1[1]); w.w = cvt_pk_bf16(v1[2], v1[3]);
                    *(u32x4*)(rowp + bj * HALF) = w; } }
    }
};
struct EpiPlainS {
    static constexpr bool PERM = true;
    bf16* O; int ldc; float osc;
    __device__ __forceinline__ void operator()(const f32x4 (&acc)[2][2][4][2], const Unit& u, int wr, int wc, int fr, int fq) const {
        const int row0 = u.pm * BM + wr * 64 + fr, col0 = u.pn * BM + wc * 32 + 8 * fq;
#pragma unroll
        for (int ai = 0; ai < 2; ++ai)
#pragma unroll
            for (int m = 0; m < 4; ++m) { bf16* rowp = O + (size_t)(row0 + ai * HALF + m * 16) * ldc + col0;
#pragma unroll
                for (int bj = 0; bj < 2; ++bj) { const f32x4 v0 = acc[ai][bj][m][0] * osc, v1 = acc[ai][bj][m][1] * osc;
                    u32x4 w; w.x = cvt_pk_bf16(v0[0], v0[1]); w.y = cvt_pk_bf16(v0[2], v0[3]); w.z = cvt_pk_bf16(v1[0], v1[1]); w.w = cvt_pk_bf16(v1[2], v1[3]);
                    *(u32x4*)(rowp + bj * HALF) = w; } }
    }
};
struct EpiSwiglu {
    static constexpr bool PERM = true;
    bf16* O; int ldc; float isc;
    __device__ __forceinline__ void operator()(const f32x4 (&acc)[2][2][4][2], const Unit& u, int wr, int wc, int fr, int fq) const {
        const int row0 = u.pm * BM + wr * 64 + fr, col0 = u.pn * HALF + wc * 32 + 8 * fq;
#pragma unroll
        for (int ai = 0; ai < 2; ++ai)
#pragma unroll
            for (int m = 0; m < 4; ++m) { bf16* rowp = O + (size_t)(row0 + ai * HALF + m * 16) * ldc + col0;
                float r[8];
#pragma unroll
                for (int n = 0; n < 2; ++n)
#pragma unroll
                    for (int j = 0; j < 4; ++j) { const float g = acc[ai][0][m][n][j] * isc, up = acc[ai][1][m][n][j] * isc;
                        const float s = __builtin_amdgcn_rcpf(1.0f + __builtin_amdgcn_exp2f(-g * LOG2E));
                        r[n * 4 + j] = g * s * up; }
                u32x4 w; w.x = cvt_pk_bf16(r[0], r[1]); w.y = cvt_pk_bf16(r[2], r[3]); w.z = cvt_pk_bf16(r[4], r[5]); w.w = cvt_pk_bf16(r[6], r[7]);
                *(u32x4*)rowp = w; }
    }
};
struct EpiQKV {
    static constexpr bool PERM = false;
    unsigned char* wsb; size_t oq, ok, ov, op, oc; const float* qg; const float* kg;
    __device__ __forceinline__ void operator()(const f32x4 (&acc)[2][2][4][2], const Unit& u, int wr, int wc, int fr, int fq) const {
        const int row0 = u.pm * BM + wr * 64 + fr;
        if (u.pn < 4) {
            const bool isq = u.pn < 3, rope = u.pm < MS / BM;
            unsigned char* Qp = wsb + oq; unsigned char* Kp = wsb + ok; const float* ct = (const float*)(wsb + oc); const float* st = ct + 4096;
            const float* gv = isq ? qg : kg;
            f32x4 gn[2][2];
#pragma unroll
            for (int bj = 0; bj < 2; ++bj)
#pragma unroll
                for (int n = 0; n < 2; ++n) gn[bj][n] = *(const f32x4*)(gv + bj * 32 + 16 * n + 4 * fq);
            const float osc = isq ? SC64 * 8.0f : 1.0f;
#pragma unroll
            for (int ai = 0; ai < 2; ++ai)
#pragma unroll
                for (int m = 0; m < 4; ++m) {
                    const int row = row0 + ai * HALF + m * 16;
                    float ss = 0.f;
#pragma unroll
                    for (int bj = 0; bj < 2; ++bj)
#pragma unroll
                        for (int n = 0; n < 2; ++n) { const f32x4 v = acc[ai][bj][m][n]; ss += (v[0] * v[0] + v[1] * v[1]) + (v[2] * v[2] + v[3] * v[3]); }
                    ss += shx(ss, 16); ss += shx(ss, 32);
                    const float rstd = osc / sqrtf(ss * (1.f / 64.f) + EPS);
                    const int t = row & (SEQ - 1);
                    unsigned char* dst = isq ? Qp + (size_t)row * 768 + (u.pn * 4 + wc) * 64 + 4 * fq : Kp + (size_t)kvrow(row) * 256 + wc * 64 + 4 * fq;
#pragma unroll
                    for (int bj = 0; bj < 2; ++bj) {
                        const int pos = bj ? (t & 63) : (t >> 6);
                        f32x4 cs = (f32x4){1.f, 1.f, 1.f, 1.f}, sn = (f32x4){0.f, 0.f, 0.f, 0.f};
                        if (rope) { cs = *(const f32x4*)(ct + pos * 16 + 4 * fq); sn = *(const f32x4*)(st + pos * 16 + 4 * fq); }
                        const f32x4 x1 = acc[ai][bj][m][0] * rstd * gn[bj][0], x2 = acc[ai][bj][m][1] * rstd * gn[bj][1];
                        const f32x4 o1 = x1 * cs - x2 * sn, o2 = x1 * sn + x2 * cs;
                        int w1 = 0, w2 = 0; w1 = __builtin_amdgcn_cvt_pk_fp8_f32(o1[0], o1[1], w1, false); w1 = __builtin_amdgcn_cvt_pk_fp8_f32(o1[2], o1[3], w1, true);
                        w2 = __builtin_amdgcn_cvt_pk_fp8_f32(o2[0], o2[1], w2, false); w2 = __builtin_amdgcn_cvt_pk_fp8_f32(o2[2], o2[3], w2, true);
                        *(int*)(dst + bj * 32) = w1; *(int*)(dst + bj * 32 + 16) = w2; }
                }
        } else {
            const bool isv = u.pn == 4; bf16* Vp = (bf16*)(wsb + ov); bf16* Pp = (bf16*)(wsb + op);
#pragma unroll
            for (int ai = 0; ai < 2; ++ai)
#pragma unroll
                for (int m = 0; m < 4; ++m) {
                    const int row = row0 + ai * HALF + m * 16;
                    bf16* dst = (isv ? Vp + (size_t)kvrow(row) * 256 : Pp + (size_t)row * 256) + wc * 32 + 4 * fq;
#pragma unroll
                    for (int bj = 0; bj < 2; ++bj)
#pragma unroll
                        for (int n = 0; n < 2; ++n) { const f32x4 v = acc[ai][bj][m][n]; u32x2 w; w.x = cvt_pk_bf16(v[0], v[1]); w.y = cvt_pk_bf16(v[2], v[3]); *(u32x2*)(dst + bj * HALF + 16 * n) = w; }
                }
        }
    }
};
struct EpiSwiglu8 {
    static constexpr bool PERM = true;
    unsigned char* O; int ldc; float isc;
    __device__ __forceinline__ void operator()(const f32x4 (&acc)[2][2][4][2], const Unit& u, int wr, int wc, int fr, int fq) const {
        const int row0 = u.pm * BM + wr * 64 + fr, col0 = u.pn * HALF + wc * 32 + 8 * fq;
#pragma unroll
        for (int ai = 0; ai < 2; ++ai)
#pragma unroll
            for (int m = 0; m < 4; ++m) { unsigned char* rowp = O + (size_t)(row0 + ai * HALF + m * 16) * ldc + col0;
                float r[8];
#pragma unroll
                for (int n = 0; n < 2; ++n)
#pragma unroll
                    for (int j = 0; j < 4; ++j) { const float g = acc[ai][0][m][n][j] * isc, up = acc[ai][1][m][n][j] * isc;
                        const float s = __builtin_amdgcn_rcpf(1.0f + __builtin_amdgcn_exp2f(-g * LOG2E));
                        r[n * 4 + j] = g * s * up * 8.0f; }
                int w0 = 0, w1 = 0; w0 = __builtin_amdgcn_cvt_pk_fp8_f32(r[0], r[1], w0, false); w0 = __builtin_amdgcn_cvt_pk_fp8_f32(r[2], r[3], w0, true);
                w1 = __builtin_amdgcn_cvt_pk_fp8_f32(r[4], r[5], w1, false); w1 = __builtin_amdgcn_cvt_pk_fp8_f32(r[6], r[7], w1, true);
                u32x2 w; w.x = (unsigned)w0; w.y = (unsigned)w1; *(u32x2*)rowp = w; }
    }
};
struct EpiSwiglu8F {
    static constexpr bool PERM = true;
    unsigned char* O; int ldc; float isc;
    __device__ __forceinline__ void operator()(const f32x4 (&acc)[2][2][4][2], const Unit& u, int wr, int wc, int fr, int fq) const {
        const int row0 = u.pm * BM + wr * 64 + fr, col0 = u.pn * HALF + wc * 32 + 8 * fq;
        const float c1 = -isc * LOG2E, c2 = 8.0f * isc * isc;
#pragma unroll
        for (int ai = 0; ai < 2; ++ai)
#pragma unroll
            for (int m = 0; m < 4; ++m) { unsigned char* rowp = O + (size_t)(row0 + ai * HALF + m * 16) * ldc + col0;
                float r[8];
#pragma unroll
                for (int n = 0; n < 2; ++n)
#pragma unroll
                    for (int j = 0; j < 4; ++j) { const float ag = acc[ai][0][m][n][j], au = acc[ai][1][m][n][j];
                        const float s = __builtin_amdgcn_rcpf(1.0f + __builtin_amdgcn_exp2f(ag * c1));
                        r[n * 4 + j] = (ag * au) * (s * c2); }
                int w0 = 0, w1 = 0; w0 = __builtin_amdgcn_cvt_pk_fp8_f32(r[0], r[1], w0, false); w0 = __builtin_amdgcn_cvt_pk_fp8_f32(r[2], r[3], w0, true);
                w1 = __builtin_amdgcn_cvt_pk_fp8_f32(r[4], r[5], w1, false); w1 = __builtin_amdgcn_cvt_pk_fp8_f32(r[6], r[7], w1, true);
                u32x2 w; w.x = (unsigned)w0; w.y = (unsigned)w1; *(u32x2*)rowp = w; }
    }
};
struct EpiKV {
    static constexpr bool PERM = true;
    unsigned char* K1p; bf16* V1p;
    __device__ __forceinline__ void operator()(const f32x4 (&acc)[2][2][4][2], const Unit& u, int wr, int wc, int fr, int fq) const {
        const int row0 = u.pm * BM + wr * 64 + fr;
        if (u.pn < 2) {
#pragma unroll
            for (int ai = 0; ai < 2; ++ai)
#pragma unroll
                for (int m = 0; m < 4; ++m) { const unsigned kr = (unsigned)kvrow(row0 + ai * HALF + m * 16) * 1024u;
#pragma unroll
                    for (int bj = 0; bj < 2; ++bj) { const f32x4 v0 = acc[ai][bj][m][0], v1 = acc[ai][bj][m][1];
                        int w0 = 0, w1 = 0; w0 = __builtin_amdgcn_cvt_pk_fp8_f32(v0[0], v0[1], w0, false); w0 = __builtin_amdgcn_cvt_pk_fp8_f32(v0[2], v0[3], w0, true);
                        w1 = __builtin_amdgcn_cvt_pk_fp8_f32(v1[0], v1[1], w1, false); w1 = __builtin_amdgcn_cvt_pk_fp8_f32(v1[2], v1[3], w1, true);
                        u32x2 w; w.x = (unsigned)w0; w.y = (unsigned)w1;
                        *(u32x2*)(K1p + (kr + (unsigned)((u.pn * 4 + bj * 2 + (wc >> 1)) * 128 + (wc & 1) * 32 + 8 * fq))) = w; } }
        } else {
#pragma unroll
            for (int ai = 0; ai < 2; ++ai)
#pragma unroll
                for (int m = 0; m < 4; ++m) { const unsigned kr = (unsigned)kvrow(row0 + ai * HALF + m * 16) * 512u;
#pragma unroll
                    for (int bj = 0; bj < 2; ++bj) { const f32x4 v0 = acc[ai][bj][m][0], v1 = acc[ai][bj][m][1];
                        u32x4 w; w.x = cvt_pk_bf16(v0[0], v0[1]); w.y = cvt_pk_bf16(v0[2], v0[3]); w.z = cvt_pk_bf16(v1[0], v1[1]); w.w = cvt_pk_bf16(v1[2], v1[3]);
                        *(u32x4*)(V1p + (kr + (unsigned)((u.pn - 2) * BM + bj * HALF + wc * 32 + 8 * fq))) = w; } }
        }
    }
};

__device__ __forceinline__ const char* uni_ptr(const char* p) {
    const unsigned lo = __builtin_amdgcn_readfirstlane((unsigned)(uintptr_t)p), hi = __builtin_amdgcn_readfirstlane((unsigned)((uintptr_t)p >> 32));
    return (const char*)(((uintptr_t)hi << 32) | lo); }
template <class Epi, class Sched, int MODE = 0>
__device__ __forceinline__ void gemm_phase(LAS unsigned char* lds, const Gemm g, const Sched& S, const Epi& E, const int wid) {
    constexpr bool F8 = (MODE == 1), I8 = (MODE == 2); constexpr int EB = MODE ? 1 : 2;
    const int lane = lane_id(), tid = wid * 64 + lane, wr = wid >> 2, wc = wid & 3, fr = lane & 15, fq = lane >> 4;
    int K_ = g.K; asm volatile("" : "+s"(K_));
    const int K = K_, nt = K * EB / (BK * 2), lda = g.lda;
    unsigned voffA[2], voffB[2];
#pragma unroll
    for (int i = 0; i < 2; ++i) { int R, C; stage_rc(tid * 16 + i * 8192, R, C); const int Rb = Epi::PERM ? ((R & ~31) + perm32(R & 31)) : R;
        voffA[i] = (unsigned)(R * lda * EB + C * 2); voffB[i] = (unsigned)(Rb * K * EB + C * 2); }
    const size_t kstep = (size_t)(BK * 2);
    const size_t hstepA = (size_t)HALF * lda * EB, tstepA = 2 * hstepA;
    const size_t hstepB = (size_t)HALF * K * EB, tstepB = 2 * hstepB;
    const unsigned ldsw = (unsigned)wid * 1024u;
    const int aoff = lds_byte(wr * 64 + fr, fq * 8), boff = lds_byte(wc * 32 + fr, fq * 8);
#define PG8_SA(b, h) (((b) * 2 + (h)) * HTB)
#define PG8_SB(b, h) ((4 + (b) * 2 + (h)) * HTB)
#define PG8_STAGE(bufoff, gbase, voff) do { const char* gb_ = (const char*)(gbase); asm volatile("" : "+s"(gb_));     \
        _Pragma("unroll") for (int _i = 0; _i < 2; ++_i) { unsigned vo_ = (voff)[_i]; asm volatile("" : "+v"(vo_));     \
        __builtin_amdgcn_global_load_lds((const unsigned*)(gb_ + vo_), (LAS unsigned*)(lds + (bufoff) + ldsw + _i * 8192), 16, 0, 0); } } while (0)
#define PG8_FR(dst, addr) do { const LAS unsigned char* p_ = (addr); if constexpr (F8) { const i32x4v lo_ = *(const LAS i32x4v*)p_, hi_ = *(const LAS i32x4v*)(p_ + 1024); *(i32x8v*)&(dst) = __builtin_shufflevector(lo_, hi_, 0, 1, 2, 3, 4, 5, 6, 7); } \
        else { ((Frag2*)&(dst))->k[0] = *(const LAS bf16x8*)p_; ((Frag2*)&(dst))->k[1] = *(const LAS bf16x8*)(p_ + 1024); } } while (0)
#define PG8_LDA(dst, b, h) do { _Pragma("unroll") for (int m = 0; m < 4; ++m) PG8_FR(dst[m], lds + PG8_SA(b, h) + aoff + m * 2048); } while (0)
#define PG8_LDB(dst, b, h) do { _Pragma("unroll") for (int n = 0; n < 2; ++n) PG8_FR(dst[n], lds + PG8_SB(b, h) + boff + n * 2048); } while (0)
#define PG8_MMA(ai, bj, At, Bt) do { __builtin_amdgcn_s_setprio(1); _Pragma("unroll") for (int m = 0; m < 4; ++m) _Pragma("unroll") for (int n = 0; n < 2; ++n) { \
        if constexpr (F8) acc[ai][bj][m][n] = __builtin_amdgcn_mfma_scale_f32_16x16x128_f8f6f4(*(const i32x8v*)&Bt[n], *(const i32x8v*)&At[m], acc[ai][bj][m][n], 0, 0, 0, 0, 0, 0); \
        else if constexpr (I8) { _Pragma("unroll") for (int k = 0; k < 2; ++k) acc[ai][bj][m][n] = __builtin_bit_cast(f32x4, __builtin_amdgcn_mfma_i32_16x16x64_i8(__builtin_bit_cast(i32x4v, ((const Frag2*)&Bt[n])->k[k]), __builtin_bit_cast(i32x4v, ((const Frag2*)&At[m])->k[k]), __builtin_bit_cast(i32x4v, acc[ai][bj][m][n]), 0, 0, 0)); } \
        else { _Pragma("unroll") for (int k = 0; k < 2; ++k) acc[ai][bj][m][n] = __builtin_amdgcn_mfma_f32_16x16x32_bf16(((const Frag2*)&Bt[n])->k[k], ((const Frag2*)&At[m])->k[k], acc[ai][bj][m][n], 0, 0, 0); } } \
        __builtin_amdgcn_s_setprio(0); } while (0)
#define PG8_WAIT_V(n) asm volatile("s_waitcnt vmcnt(" #n ")" ::: "memory")
#define PG8_WAIT_L(n) asm volatile("s_waitcnt lgkmcnt(" #n ")" ::: "memory")
#define PG8_BAR __builtin_amdgcn_s_barrier()
#define PG8_SCHED __builtin_amdgcn_sched_barrier(0)
    Unit cur, nxt; int ui = 0;
    if (!S.next(0, cur)) return;
    f32x4 acc[2][2][4][2];
#pragma unroll
    for (int a = 0; a < 2; ++a)
#pragma unroll
        for (int b = 0; b < 2; ++b)
#pragma unroll
            for (int m = 0; m < 4; ++m)
#pragma unroll
                for (int n = 0; n < 2; ++n) acc[a][b][m][n] = (f32x4){0.f, 0.f, 0.f, 0.f};
    typename FragT<MODE>::A At[4]; typename FragT<MODE>::A B0[2], B1[2];
    const char* cA = uni_ptr((const char*)g.A + (size_t)cur.pm * tstepA); const char* cB = uni_ptr((const char*)g.Bt + (size_t)cur.pn * tstepB + (size_t)cur.e * g.estride);
    PG8_STAGE(PG8_SB(0, 0), cB, voffB); PG8_STAGE(PG8_SB(0, 1), cB + hstepB, voffB); PG8_STAGE(PG8_SA(0, 0), cA, voffA); PG8_STAGE(PG8_SA(0, 1), cA + hstepA, voffA);
    if (wr == 1) PG8_BAR;
    PG8_WAIT_V(2); PG8_BAR;
    PG8_STAGE(PG8_SB(1, 0), cB + kstep, voffB); PG8_STAGE(PG8_SA(1, 0), cA + kstep, voffA); PG8_STAGE(PG8_SB(1, 1), cB + hstepB + kstep, voffB);
    PG8_WAIT_V(6); PG8_BAR;
    for (;;) {
        const bool has_next = S.next(ui + 1, nxt);
        const char* nA = uni_ptr(has_next ? (const char*)g.A + (size_t)nxt.pm * tstepA : cA);
        const char* nB = uni_ptr(has_next ? (const char*)g.Bt + (size_t)nxt.pn * tstepB + (size_t)nxt.e * g.estride : cB);
        for (int t = 0; t < nt; t += 2) {
            const bool last = (t == nt - 2);
            const char* a1 = cA + (size_t)(t + 1) * kstep;
            const char* a2 = last ? nA : cA + (size_t)(t + 2) * kstep; const char* b2 = last ? nB : cB + (size_t)(t + 2) * kstep;
            const char* a3 = a2 + kstep; const char* b3 = b2 + kstep;
            PG8_LDB(B0, 0, 0); PG8_LDB(B1, 0, 1); PG8_SCHED; PG8_LDA(At, 0, 0); PG8_STAGE(PG8_SA(1, 1), a1 + hstepA, voffA);
            PG8_WAIT_V(8); PG8_WAIT_L(0); PG8_BAR; PG8_MMA(0, 0, At, B0); PG8_MMA(0, 1, At, B1); PG8_BAR; PG8_SCHED;
            PG8_LDA(At, 0, 1); PG8_STAGE(PG8_SB(0, 0), b2, voffB); PG8_STAGE(PG8_SB(0, 1), b2 + hstepB, voffB); PG8_STAGE(PG8_SA(0, 0), a2, voffA);
            PG8_WAIT_V(8); PG8_WAIT_L(0); PG8_BAR; PG8_MMA(1, 0, At, B0); PG8_MMA(1, 1, At, B1); PG8_BAR; PG8_SCHED;
            PG8_LDB(B0, 1, 0); PG8_LDB(B1, 1, 1); PG8_SCHED; PG8_LDA(At, 1, 0); PG8_STAGE(PG8_SA(0, 1), a2 + hstepA, voffA);
            PG8_WAIT_V(8); PG8_WAIT_L(0); PG8_BAR; PG8_MMA(0, 0, At, B0); PG8_MMA(0, 1, At, B1); PG8_BAR; PG8_SCHED;
            PG8_LDA(At, 1, 1); PG8_STAGE(PG8_SB(1, 0), b3, voffB); PG8_STAGE(PG8_SB(1, 1), b3 + hstepB, voffB); PG8_STAGE(PG8_SA(1, 0), a3, voffA);
            PG8_WAIT_V(8); PG8_WAIT_L(0); PG8_BAR; PG8_MMA(1, 0, At, B0); PG8_MMA(1, 1, At, B1); PG8_BAR; PG8_SCHED;
        }
        if (wr == 0) PG8_BAR;
        if constexpr (I8) {
            const float* qwp = g.qw + (size_t)cur.e * g.qwstride + cur.pn * BM + wc * 32 + (Epi::PERM ? 8 * fq : 4 * fq);
            f32x4 sw_[2][2];
#pragma unroll
            for (int b = 0; b < 2; ++b)
#pragma unroll
                for (int n = 0; n < 2; ++n) sw_[b][n] = *(const f32x4*)(qwp + b * HALF + (Epi::PERM ? 4 : 16) * n);
            const float* qap = g.qa + cur.pm * BM + wr * 64 + fr;
#pragma unroll
            for (int a = 0; a < 2; ++a)
#pragma unroll
                for (int m = 0; m < 4; ++m) { const float sr = qap[a * HALF + m * 16];
#pragma unroll
                    for (int b = 0; b < 2; ++b)
#pragma unroll
                        for (int n = 0; n < 2; ++n) { const i32x4v iv = __builtin_bit_cast(i32x4v, acc[a][b][m][n]);
                            const f32x4 sc = sw_[b][n] * sr; acc[a][b][m][n] = (f32x4){(float)iv[0] * sc[0], (float)iv[1] * sc[1], (float)iv[2] * sc[2], (float)iv[3] * sc[3]}; } }
            __builtin_amdgcn_sched_barrier(0);
        }
        E(acc, cur, wr, wc, fr, fq);
        if (!has_next) break;
#pragma unroll
        for (int a = 0; a < 2; ++a)
#pragma unroll
            for (int b = 0; b < 2; ++b)
#pragma unroll
                for (int m = 0; m < 4; ++m)
#pragma unroll
                    for (int n = 0; n < 2; ++n) acc[a][b][m][n] = (f32x4){0.f, 0.f, 0.f, 0.f};
        cur = nxt; cA = nA; cB = nB; ++ui;
        if (wr == 1) PG8_BAR;
    }
    PG8_WAIT_V(0);
    PG8_BAR;
#undef PG8_SA
#undef PG8_SB
#undef PG8_STAGE
#undef PG8_LDA
#undef PG8_LDB
#undef PG8_MMA
#undef PG8_FR
#undef PG8_WAIT_V
#undef PG8_WAIT_L
#undef PG8_BAR
#undef PG8_SCHED
}
}

namespace att {
constexpr int KSLOT = 12288, VSLOT = 8192;
constexpr int NSL = 4;
constexpr int L_K = 0, L_V = NSL * KSLOT, L_WS = L_V + NSL * VSLOT, L_OST = L_WS + 2048, L_BIAS = L_OST + 32768, L_END = L_BIAS + 2048;
typedef LAS const char* lds_cptr;
__device__ __forceinline__ int crow(int r, int hi) { return (r & 3) + 8 * (r >> 2) + 4 * hi; }
__device__ __forceinline__ void glds16(const void* gsrc, unsigned lds_dst) { unsigned keep;
    asm volatile("s_mov_b32 %0, m0\n\ts_mov_b32 m0, %2\n\ts_nop 0\n\tglobal_load_lds_dwordx4 %1, off\n\ts_mov_b32 m0, %0" : "=&s"(keep) : "v"(gsrc), "s"(lds_dst) : "memory"); }
typedef __bf16 bf16x2_t __attribute__((ext_vector_type(2)));
__device__ __forceinline__ unsigned cvtpk_s(float lo, float hi) { f32x2 v = {lo, hi}; bf16x2_t b = __builtin_convertvector(v, bf16x2_t); return __builtin_bit_cast(unsigned, b); }
#define ATT_WAIT_BAR() asm volatile("s_waitcnt vmcnt(0) lgkmcnt(0)\n\ts_barrier" ::: "memory")
__device__ __forceinline__ v4i16_t vtr(lds_cptr p) { return __builtin_amdgcn_ds_read_tr16_b64_v4i16((LAS v4i16_t*)p); }

struct NoMask {
    __device__ __forceinline__ long tile_row(int t) const { return (long)t * 64; }
    __device__ __forceinline__ bool active(int) const { return true; }
    __device__ __forceinline__ void apply(f32x16&, f32x16&, int, int) const {}
};
struct NaMask {
    long ctx_row0, seq_row0; int kr0, r, rs, j, cs; const LAS float* bias;
    __device__ __forceinline__ long tile_row(int t) const { return t < 4 ? ctx_row0 + 64 * t : seq_row0 + (long)(kr0 + t - 4) * 64; }
    __device__ __forceinline__ bool active(int t) const { const int kr = kr0 + t - 4; return t < 4 || (kr >= rs && kr < rs + 8); }
    __device__ __forceinline__ void apply(f32x16& p0, f32x16& p1, int t, int hi) const {
        if (t < 4) return;
        const int kr = kr0 + t - 4; const int bi = (kr - r + 7) * 31 + 15 - j;
#pragma unroll
        for (int q = 0; q < 16; ++q) { const int k0 = crow(q, hi), k1 = k0 + 32;
            const bool v0 = (k0 >= cs) && (k0 < cs + 16), v1 = (k1 >= cs) && (k1 < cs + 16);
            const float b0 = v0 ? bias[bi + k0] : 0.f, b1 = v1 ? bias[bi + k1] : 0.f;
            p0[q] = v0 ? p0[q] + b0 : -INFINITY; p1[q] = v1 ? p1[q] + b1 : -INFINITY; }
    }
};

template <int DK, class MK>
__device__ __forceinline__ void attn_unit(const bf16* Qw, int qpitch, const bf16* Kb, int kpitch, const bf16* Vb, int vpitch, bf16* Ow, int opitch, int NT, const MK& mk, LAS unsigned char* shm, const int wid) {
    constexpr int ND = DK / 16, NCH = DK / 8;
    const int lane = lane_id(), r32 = lane & 31, hi = lane >> 5;
    const unsigned lds0 = (unsigned)(uintptr_t)shm;
    const lds_cptr shm3 = (lds_cptr)shm;
    LAS float* wsf = (LAS float*)(shm + L_WS) + wid * 64;
    const bf16* ksrc = Kb + (long)lane * kpitch + wid * 8;
    const bf16* vsrc = Vb + (long)(16 * (wid & 3) + (lane >> 2)) * vpitch + (wid >> 2) * 32 + (lane & 3) * 8;
#define ATT_DMA(t, slot) do { const long r0_ = mk.tile_row(t); \
        glds16(ksrc + r0_ * kpitch, (unsigned)(lds0 + L_K + (slot) * KSLOT + wid * 1024)); \
        if (NCH > 8) { if (wid < NCH - 8) glds16(ksrc + r0_ * kpitch + 64, (unsigned)(lds0 + L_K + (slot) * KSLOT + (wid + 8) * 1024)); } \
        glds16(vsrc + r0_ * vpitch, (unsigned)(lds0 + L_V + (slot) * VSLOT + wid * 1024)); } while (0)
    ATT_DMA(0, 0);
    bf16x8 qr[ND];
#pragma unroll
    for (int d0 = 0; d0 < ND; ++d0) qr[d0] = *(const bf16x8*)(Qw + (long)r32 * qpitch + d0 * 16 + hi * 8);
    float mhat = -1e30f, l_reg = 0.f; f32x16 o[2]; o[0] = f32x16{}; o[1] = f32x16{};
    const int kfo = hi * 1024 + r32 * 16;
    const int vfo = ((lane >> 4) & 1) * 32 + (lane & 3) * 8 + (4 * hi + ((lane & 15) >> 2)) * 64;
    constexpr int DPT = (NCH > 8) ? 3 : 2;
    if (NT > 1) ATT_DMA(1, 1); if (NT > 2) ATT_DMA(2, 2);
    for (int t = 0; t < NT; ++t) {
        if (t + 2 < NT) { if (DPT == 3 && wid < NCH - 8) asm volatile("s_waitcnt vmcnt(6) lgkmcnt(0)\n\ts_barrier" ::: "memory"); else asm volatile("s_waitcnt vmcnt(4) lgkmcnt(0)\n\ts_barrier" ::: "memory"); }
        else if (t + 1 < NT) { if (DPT == 3 && wid < NCH - 8) asm volatile("s_waitcnt vmcnt(3) lgkmcnt(0)\n\ts_barrier" ::: "memory"); else asm volatile("s_waitcnt vmcnt(2) lgkmcnt(0)\n\ts_barrier" ::: "memory"); }
        else ATT_WAIT_BAR();
        if (t + 3 < NT) ATT_DMA(t + 3, (t + 3) & 3);
        if (mk.active(t)) {
            const lds_cptr kp = shm3 + L_K + (t & 3) * KSLOT + kfo;
            f32x16 p0 = f32x16{}, p1 = f32x16{};
#pragma unroll
            for (int d0 = 0; d0 < ND; ++d0) {
                const bf16x8 b0 = *(const LAS bf16x8*)(kp + d0 * 2048), b1 = *(const LAS bf16x8*)(kp + d0 * 2048 + 512);
                p0 = __builtin_amdgcn_mfma_f32_32x32x16_bf16(b0, qr[d0], p0, 0, 0, 0);
                p1 = __builtin_amdgcn_mfma_f32_32x32x16_bf16(b1, qr[d0], p1, 0, 0, 0); }
            mk.apply(p0, p1, t, hi);
            float rm = __builtin_fmaxf(p0[0], p1[0]);
#pragma unroll
            for (int r = 1; r < 16; ++r) rm = __builtin_fmaxf(rm, __builtin_fmaxf(p0[r], p1[r]));
            { auto rr = __builtin_amdgcn_permlane32_swap(__float_as_uint(rm), __float_as_uint(rm), false, false); rm = __builtin_fmaxf(__uint_as_float(rr[0]), __uint_as_float(rr[1])); }
            if (__any(rm > mhat + 8.0f)) {
                const float mn = __builtin_fmaxf(mhat, rm); const float f = __builtin_amdgcn_exp2f(mhat - mn); l_reg *= f; mhat = mn;
                if (hi == 0) wsf[r32] = f;
                LDS_WAIT();
#pragma unroll
                for (int d = 0; d < 2; ++d)
#pragma unroll
                    for (int r = 0; r < 16; ++r) o[d][r] *= wsf[crow(r, hi)];
            }
            float sacc = 0.f;
#pragma unroll
            for (int r = 0; r < 16; ++r) { p0[r] = __builtin_amdgcn_exp2f(p0[r] - mhat); p1[r] = __builtin_amdgcn_exp2f(p1[r] - mhat); sacc += p0[r] + p1[r]; }
            l_reg += sacc;
            u32x4 pw0, pw1, pw2, pw3;
            pw0 = (u32x4){cvtpk_s(p0[0], p0[1]), cvtpk_s(p0[2], p0[3]), cvtpk_s(p0[4], p0[5]), cvtpk_s(p0[6], p0[7])};
            pw1 = (u32x4){cvtpk_s(p0[8], p0[9]), cvtpk_s(p0[10], p0[11]), cvtpk_s(p0[12], p0[13]), cvtpk_s(p0[14], p0[15])};
            pw2 = (u32x4){cvtpk_s(p1[0], p1[1]), cvtpk_s(p1[2], p1[3]), cvtpk_s(p1[4], p1[5]), cvtpk_s(p1[6], p1[7])};
            pw3 = (u32x4){cvtpk_s(p1[8], p1[9]), cvtpk_s(p1[10], p1[11]), cvtpk_s(p1[12], p1[13]), cvtpk_s(p1[14], p1[15])};
            const bf16x8 pa[4] = {__builtin_bit_cast(bf16x8, pw0), __builtin_bit_cast(bf16x8, pw1), __builtin_bit_cast(bf16x8, pw2), __builtin_bit_cast(bf16x8, pw3)};
            const lds_cptr vp = shm3 + L_V + (t & 3) * VSLOT + vfo;
#pragma unroll
            for (int d0 = 0; d0 < 2; ++d0)
#pragma unroll
                for (int ks = 0; ks < 4; ++ks) {
                    const v4i16_t lo = vtr(vp + d0 * 4096 + ks * 1024), hh = vtr(vp + d0 * 4096 + ks * 1024 + 512);
                    const bf16x8 vf = (bf16x8){lo[0], lo[1], lo[2], lo[3], hh[0], hh[1], hh[2], hh[3]};
                    o[d0] = __builtin_amdgcn_mfma_f32_32x32x16_bf16(pa[ks], vf, o[d0], 0, 0, 0); }
        }
    }
#undef ATT_DMA
    { auto rr = __builtin_amdgcn_permlane32_swap(__float_as_uint(l_reg), __float_as_uint(l_reg), false, false); l_reg = __uint_as_float(rr[0]) + __uint_as_float(rr[1]); }
    if (hi == 0) wsf[32 + r32] = l_reg;
    LDS_WAIT();
    float rli[16];
#pragma unroll
    for (int r = 0; r < 16; ++r) rli[r] = 1.0f / wsf[32 + crow(r, hi)];
    { LAS bf16* stg = (LAS bf16*)(shm + L_OST) + wid * 2048;
#pragma unroll
        for (int r = 0; r < 16; ++r) { const int orow = crow(r, hi);
#pragma unroll
            for (int d0 = 0; d0 < 2; ++d0) stg[orow * 64 + d0 * 32 + r32] = (bf16)f2bf(o[d0][r] * rli[r]); }
        LDS_WAIT();
#pragma unroll
        for (int i = 0; i < 4; ++i) { const int row = i * 8 + (lane >> 3), ch = lane & 7; const u32x4 v = *(const LAS u32x4*)(stg + row * 64 + ch * 8); *(u32x4*)(Ow + (long)row * opitch + ch * 8) = v; } }
    asm volatile("s_waitcnt lgkmcnt(0)\n\ts_barrier" ::: "memory");
}
}


namespace att64q8 {
typedef int i32x8 __attribute__((ext_vector_type(8)));
#define M8(a,b,c) __builtin_amdgcn_mfma_scale_f32_32x32x64_f8f6f4((a),(b),(c),0,0,0,0x7f7f7f7f,0,0x7c7c7c7c)
#define MPV(a,b,c) __builtin_amdgcn_mfma_scale_f32_32x32x64_f8f6f4((a),(b),(c),1,0,0,0x7f7f7f7f,0,0x7f7f7f7f)
constexpr int NW=8,QBLK=32,QB=QBLK*NW,KVBLK=64;
__device__ __forceinline__ int crow(int r,int hi){return (r&3)+8*(r>>2)+4*hi;}
#define SBAR() __builtin_amdgcn_sched_barrier(0)

constexpr int NSLOT=3, SLOTB=8192;
constexpr int LDS_K=0, LDS_V=NSLOT*SLOTB, LDS_WS=2*NSLOT*SLOTB, LDS_OST=LDS_WS+NW*64*4, LDS_BYTES=LDS_OST+NW*4096;
constexpr float C2=0.125f*1.4426950408889634f;
__device__ __forceinline__ void glds16(const void*gsrc,unsigned lds_dst){unsigned keep;
  asm volatile("s_mov_b32 %0, m0\n\ts_mov_b32 m0, %2\n\ts_nop 0\n\tglobal_load_lds_dwordx4 %1, off\n\ts_mov_b32 m0, %0":"=&s"(keep):"v"(gsrc),"s"(lds_dst):"memory");}
__device__ __forceinline__ float max3f(float a,float b,float c){float r;asm("v_max3_f32 %0, %1, %2, %3":"=v"(r):"v"(a),"v"(b),"v"(c));return r;}
__device__ __forceinline__ float max2f(float a,float b){float r;asm("v_max_f32_e32 %0, %1, %2":"=v"(r):"v"(a),"v"(b));return r;}
__device__ __forceinline__ float fadd_s(float a,float b){float r;asm("v_add_f32_e32 %0, %1, %2":"=v"(r):"v"(a),"v"(b));return r;}
__device__ __forceinline__ float fsub_s(float a,float b){float r;asm("v_sub_f32_e32 %0, %1, %2":"=v"(r):"v"(a),"v"(b));return r;}
typedef float f32x2_t __attribute__((ext_vector_type(2))); typedef __bf16 bf16x2_t __attribute__((ext_vector_type(2))); typedef short s16x4 __attribute__((ext_vector_type(4)));
__device__ __forceinline__ unsigned cvtpk_s(float lo,float hi){f32x2_t v={lo,hi};bf16x2_t b=__builtin_convertvector(v,bf16x2_t);return __builtin_bit_cast(unsigned,b);}
#define WAIT_BAR(N) asm volatile("s_waitcnt vmcnt(" #N ") lgkmcnt(0)\n\ts_barrier":::"memory")

__device__ __forceinline__ void qkt(f32x16&p0,f32x16&p1,const char*Kslot,const i32x8&q8,const f32x16&negm,int r32,int hi){
  const int sw=(r32>>2)&3; const char*k0=Kslot+r32*64; const int c0=((2*hi)^sw)<<4, c1=((2*hi+1)^sw)<<4;
  const u32x4 a0=*reinterpret_cast<const u32x4*>(k0+c0), a1=*reinterpret_cast<const u32x4*>(k0+c1), b0=*reinterpret_cast<const u32x4*>(k0+2048+c0), b1=*reinterpret_cast<const u32x4*>(k0+2048+c1);
  const i32x8 ka={(int)a0.x,(int)a0.y,(int)a0.z,(int)a0.w,(int)a1.x,(int)a1.y,(int)a1.z,(int)a1.w}, kb={(int)b0.x,(int)b0.y,(int)b0.z,(int)b0.w,(int)b1.x,(int)b1.y,(int)b1.z,(int)b1.w};
  p0=M8(ka,q8,negm); p1=M8(kb,q8,negm);
}
typedef __attribute__((address_space(3))) const char* lds_cptr;
typedef short v4i16_t __attribute__((ext_vector_type(4)));
__device__ __forceinline__ i32x8 kfr(lds_cptr p0,lds_cptr p1){ const u32x4 a=*(const __attribute__((address_space(3))) u32x4*)p0, b=*(const __attribute__((address_space(3))) u32x4*)p1;
  return (i32x8){(int)a.x,(int)a.y,(int)a.z,(int)a.w,(int)b.x,(int)b.y,(int)b.z,(int)b.w}; }
__device__ __forceinline__ s16x4 vtr(lds_cptr p){ return __builtin_bit_cast(s16x4,__builtin_amdgcn_ds_read_tr16_b64_v4i16((__attribute__((address_space(3))) v4i16_t*)p)); }
__device__ __forceinline__ float rowmax(const f32x16&p0,const f32x16&p1){
  float a=max3f(p0[0],p0[1],p1[0]),b=max3f(p0[2],p0[3],p1[1]);a=max3f(a,p1[2],p1[3]);
  #pragma unroll
  for(int r=4;r<16;r+=4){a=max3f(a,p0[r],p0[r+1]);b=max3f(b,p0[r+2],p0[r+3]);a=max3f(a,p1[r],p1[r+1]);b=max3f(b,p1[r+2],p1[r+3]);}
  const float m=max2f(a,b);
  auto rr=__builtin_amdgcn_permlane32_swap(__float_as_uint(m),__float_as_uint(m),false,false);
  return max2f(__uint_as_float(rr[0]),__uint_as_float(rr[1]));
}
__device__ __forceinline__ void pv(f32x16*o,int vb,bf16x8 pa0,bf16x8 pa1,bf16x8 pa2,bf16x8 pa3){
  #pragma unroll
  for(int d0=0;d0<2;++d0){s16x4 lo[4],hi[4];
    #pragma unroll
    for(int ks=0;ks<4;++ks){
      asm volatile("ds_read_b64_tr_b16 %0,%1 offset:%c2":"=&v"(lo[ks]):"v"(vb),"i"(d0*4096+ks*1024):"memory");
      asm volatile("ds_read_b64_tr_b16 %0,%1 offset:%c2":"=&v"(hi[ks]):"v"(vb),"i"(d0*4096+ks*1024+512):"memory");}
    asm volatile("s_waitcnt lgkmcnt(0)":::"memory");SBAR();
    #define PK(k) (bf16x8){lo[k][0],lo[k][1],lo[k][2],lo[k][3],hi[k][0],hi[k][1],hi[k][2],hi[k][3]}
    o[d0]=__builtin_amdgcn_mfma_f32_32x32x16_bf16(pa0,PK(0),o[d0],0,0,0);
    o[d0]=__builtin_amdgcn_mfma_f32_32x32x16_bf16(pa1,PK(1),o[d0],0,0,0);
    o[d0]=__builtin_amdgcn_mfma_f32_32x32x16_bf16(pa2,PK(2),o[d0],0,0,0);
    o[d0]=__builtin_amdgcn_mfma_f32_32x32x16_bf16(pa3,PK(3),o[d0],0,0,0);
    #undef PK
  }
}

#ifndef ATTN_STORE16
#define ATTN_STORE16(p,v) (*(u32x4*)(p)=(v))
#endif

template<int THRL,int QP,int KP,int VP,int OP,int FIX=0> __device__ __forceinline__ bool attn_unit(const unsigned char*Qu,const unsigned char*__restrict__ Kh,const unsigned char*__restrict__ Vh,bf16*Ou,const int NT,char*shm,const int wid,const float refB=0.f){
  const int lane=lane_id(),r32=lane&31,hi=lane>>5;
  const unsigned char*Qw=Qu+(long)wid*QBLK*QP;
  const unsigned lds0=(unsigned)(uintptr_t)shm;
  float*wsf=(float*)(shm+LDS_WS)+wid*64;
  const int kkey=(wid&3)*16+(lane>>2);
  const unsigned char*ksrc=Kh+(long)kkey*KP+(((lane&3)^((kkey>>2)&3))<<4);
  const unsigned char*vsrc=(const unsigned char*)Vh+(wid&3)*1024+lane*16;
  const unsigned kdst=lds0+LDS_K+(wid&3)*1024, vdst=lds0+LDS_V+(wid&3)*1024;
  #define DMA_K(t,slot) glds16(ksrc+(long)(t)*KVBLK*KP,(unsigned)(kdst+(slot)))
  #define DMA_V(t,slot) glds16(vsrc+(long)(t)*4096,(unsigned)(vdst+(slot)))
  const char*Kbase=shm+LDS_K; i32x8 kf8[2];
  const lds_cptr shm3=(lds_cptr)shm; const lds_cptr kpc0=shm3+LDS_K+r32*64+((((2*hi)^((r32>>2)&3)))<<4), kpc1=shm3+LDS_K+r32*64+((((2*hi+1)^((r32>>2)&3)))<<4);
  DMA_K(0,0);DMA_V(0,0);DMA_K(1,SLOTB);
  const i32x8 q8=*reinterpret_cast<const i32x8*>(Qw+(long)r32*QP+hi*32);
  constexpr float POFF = FIX ? 15.0f : 7.0f;
  float mhat=0.f;f32x16 o[2];o[0]=f32x16{};o[1]=f32x16{};f32x16 ls=f32x16{};f32x16 negm=f32x16{};
  { _Pragma("unroll") for(int r=0;r<16;++r)negm[r]=FIX?(POFF-refB):POFF; } asm volatile("":"+v"(negm));
  i32x8 ones8={0x38383838,0x38383838,0x38383838,0x38383838,0x38383838,0x38383838,0x38383838,0x38383838}; asm volatile("":"+v"(ones8));
  const lds_cptr vpc0=shm3+LDS_V+r32*64+((((2*hi)^((r32>>2)&3)))<<4), vpc1=shm3+LDS_V+r32*64+((((2*hi+1)^((r32>>2)&3)))<<4);
  #define CMASK(P0,P1,t) do{}while(0)
  bool resc=false;
  #define START(P0,P1) do{ if constexpr(!FIX){ const float rm=rowmax(P0,P1)-POFF; resc=false; \
    { const float dl=rm; mhat=fadd_s(mhat,dl); \
      _Pragma("unroll") for(int r=0;r<16;++r){P0[r]=fsub_s(P0[r],dl);P1[r]=fsub_s(P1[r],dl);} \
      _Pragma("unroll") for(int r=0;r<16;++r)negm[r]=POFF-mhat; asm volatile("":"+v"(negm)); } } \
    _Pragma("unroll") for(int r=0;r<16;++r)P0[r]=__builtin_amdgcn_exp2f(P0[r]); }while(0)
  #define RESC() do{ if constexpr(!FIX) if(resc){ asm volatile("s_waitcnt lgkmcnt(0)":::"memory"); \
      _Pragma("unroll") for(int r=0;r<16;++r){ const float f_=wsf[crow(r,hi)]; o[0][r]*=f_; o[1][r]*=f_; ls[r]*=f_; } } }while(0)
  f32x16 pA0,pA1,pB0,pB1;
  int sl_prev=0,sl_cur=0,sl_next=SLOTB;
  #define ROT() do{sl_prev=sl_cur;sl_cur=sl_next;sl_next=(sl_next==(NSLOT-1)*SLOTB)?0:sl_next+SLOTB;}while(0)
  DMA_K(2,2*SLOTB);
  WAIT_BAR(3);
  qkt(pA0,pA1,Kbase,q8,negm,r32,hi);asm volatile("s_nop 15\n\ts_nop 7":"+v"(pA0),"+v"(pA1));CMASK(pA0,pA1,0);
  START(pA0,pA1);
  _Pragma("unroll") for(int r=0;r<16;++r)pA1[r]=__builtin_amdgcn_exp2f(pA1[r]);
  WAIT_BAR(0);
  DMA_K(3,0);DMA_V(1,SLOTB);
  ROT();
  kf8[0]=kfr(kpc0+sl_cur,kpc1+sl_cur); kf8[1]=kfr(kpc0+sl_cur+2048,kpc1+sl_cur+2048);
  WAIT_BAR(2);
  i32x8 pb=i32x8{}, vf0, vf1;
  #define PIN(x) asm volatile("":"+v"(x))
  #define MX3(a,b,c) __builtin_fmaxf(__builtin_fmaxf((a),(b)),(c))
  #define EX(v) __builtin_amdgcn_exp2f(v)
  #define PK8(P,B,OLD,HI) __builtin_amdgcn_cvt_pk_bf8_f32(P[B],P[(B)+1],OLD,HI)
  #define CV8(P,D0) do{ int x0_=pb[(D0)],x1_=pb[(D0)+1],x2_=pb[(D0)+2],x3_=pb[(D0)+3];        \
      x0_=PK8(P,0,x0_,false); x0_=PK8(P,2,x0_,true); x1_=PK8(P,4,x1_,false); x1_=PK8(P,6,x1_,true); \
      x2_=PK8(P,8,x2_,false); x2_=PK8(P,10,x2_,true); x3_=PK8(P,12,x3_,false); x3_=PK8(P,14,x3_,true); \
      pb[(D0)]=x0_; pb[(D0)+1]=x1_; pb[(D0)+2]=x2_; pb[(D0)+3]=x3_; }while(0)
  #define EX8(X,B) do{ X[(B)]=EX(X[(B)]); X[(B)+1]=EX(X[(B)+1]); X[(B)+2]=EX(X[(B)+2]); X[(B)+3]=EX(X[(B)+3]); X[(B)+4]=EX(X[(B)+4]); X[(B)+5]=EX(X[(B)+5]); X[(B)+6]=EX(X[(B)+6]); X[(B)+7]=EX(X[(B)+7]); PIN(X); }while(0)
  #define KRD(G,j) do{ if(G){ kf8[j]=kfr(kpc0+sl_next+(j)*2048,kpc1+sl_next+(j)*2048); SBAR(); } }while(0)
  #define STEP(C0,C1,P0,P1,t,GK,GV,GL) do{ SBAR(); \
    vf0=kfr(vpc0+sl_prev,vpc1+sl_prev); vf1=kfr(vpc0+sl_prev+2048,vpc1+sl_prev+2048); SBAR(); \
    C0=M8(kf8[0],q8,negm); CV8(P0,0); PIN(pb); SBAR(); \
    C1=M8(kf8[1],q8,negm); CV8(P1,4); PIN(pb); SBAR(); \
    if(GK){DMA_K((t)+3,sl_cur);} if(GV){DMA_V((t)+1,sl_next);} \
    CMASK(C0,C1,t); \
    if constexpr(!FIX){ float a=MX3(C0[0],C0[1],C1[0]),b=MX3(C0[2],C0[3],C1[1]); a=MX3(a,C1[2],C1[3]); \
      _Pragma("unroll") for(int r=4;r<16;r+=4){a=MX3(a,C0[r],C0[r+1]);b=MX3(b,C0[r+2],C0[r+3]);a=MX3(a,C1[r],C1[r+1]);b=MX3(b,C1[r+2],C1[r+3]);} \
      float rm=__builtin_fmaxf(a,b); { auto rr=__builtin_amdgcn_permlane32_swap(__float_as_uint(rm),__float_as_uint(rm),false,false); rm=__builtin_fmaxf(__uint_as_float(rr[0]),__uint_as_float(rr[1])); } \
      rm-=POFF; resc=false; \
      if(__builtin_expect(__any(rm>(float)THRL),0)){ const float dl=__builtin_fmaxf(rm,0.f); mhat+=dl; \
        _Pragma("unroll") for(int r=0;r<16;++r){C0[r]-=dl;C1[r]-=dl;} \
        _Pragma("unroll") for(int r=0;r<16;++r)negm[r]=POFF-mhat; asm volatile("":"+v"(negm)); \
        const float f=__builtin_amdgcn_exp2f(-dl); if(hi==0)wsf[r32]=f; resc=true; } } \
    SBAR(); \
    o[0]=MPV(pb,vf0,o[0]); EX8(C0,0); SBAR(); \
    KRD(GL,0); o[1]=MPV(pb,vf1,o[1]); EX8(C0,8); SBAR(); \
    KRD(GL,1); ls=MPV(pb,ones8,ls); EX8(C1,0); SBAR(); \
    EX8(C1,8); SBAR(); \
    }while(0)
  if(wid>=4)__builtin_amdgcn_s_setprio(1);
  int t=1;
  for(;t+5<NT;t+=2){
    STEP(pB0,pB1,pA0,pA1,t,true,true,true);     WAIT_BAR(2); RESC(); ROT();
    STEP(pA0,pA1,pB0,pB1,t+1,true,true,true);   WAIT_BAR(2); RESC(); ROT();
  }
  #define ENDW(tt) do{ if((tt)+3<NT){WAIT_BAR(2);} else if((tt)+2<NT){WAIT_BAR(1);} else {WAIT_BAR(0);} }while(0)
  for(;t+1<NT;t+=2){
    STEP(pB0,pB1,pA0,pA1,t,(t+3<NT),(t+1<NT),(t+1<NT));       ENDW(t);   RESC(); ROT();
    STEP(pA0,pA1,pB0,pB1,t+1,(t+4<NT),(t+2<NT),(t+2<NT));     ENDW(t+1); RESC(); ROT();
  }
  STEP(pB0,pB1,pA0,pA1,NT-1,false,false,false); RESC();
  { CV8(pB0,0); CV8(pB1,4); PIN(pb); SBAR();
    vf0=kfr(vpc0+sl_cur,vpc1+sl_cur); vf1=kfr(vpc0+sl_cur+2048,vpc1+sl_cur+2048);
    o[0]=MPV(pb,vf0,o[0]); o[1]=MPV(pb,vf1,o[1]); ls=MPV(pb,ones8,ls); }
  #undef PIN
  #undef MX3
  #undef EX
  #undef PK8
  #undef CV8
  #undef EX8
  #undef KRD
  #undef STEP
  #undef ENDW
  __builtin_amdgcn_s_setprio(0);
  float rli[16]; float lmin=ls[0];
  #pragma unroll
  for(int r=0;r<16;++r){ rli[r]=__builtin_amdgcn_rcpf(ls[r]); lmin=__builtin_fminf(lmin,ls[r]); }
  const bool sunk=FIX&&__any(!(lmin>=1.0f));
  bf16*Ow=Ou+(long)wid*QBLK*OP;
  { bf16*stg=(bf16*)(shm+LDS_OST)+wid*2048;
    #pragma unroll
    for(int r=0;r<16;++r){const int orow=crow(r,hi);
      #pragma unroll
      for(int d0=0;d0<2;++d0)stg[orow*64+d0*32+r32]=(bf16)f2bf(o[d0][r]*rli[r]);}
    asm volatile("s_waitcnt lgkmcnt(0)":::"memory");
    #pragma unroll
    for(int i=0;i<4;++i){const int row=i*8+(lane>>3),ch=lane&7; const u32x4 v=*(const u32x4*)(stg+row*64+ch*8); ATTN_STORE16(Ow+(long)row*OP+ch*8,v);} }
  asm volatile("s_waitcnt lgkmcnt(0)\n\ts_barrier":::"memory");
  #undef DMA_K
  #undef DMA_V
  #undef CMASK
  #undef START
  #undef RESC
  #undef ROT
  return sunk;
}

#undef SBAR
#undef WAIT_BAR
constexpr int ATTN_LDS_BYTES=LDS_BYTES;
#undef M8
}

namespace att96q8 {
typedef int i32x8 __attribute__((ext_vector_type(8)));
#define M8(a,b,c) __builtin_amdgcn_mfma_scale_f32_32x32x64_f8f6f4((a),(b),(c),0,0,0,0x7f7f7f7f,0,0x7c7c7c7c)
#define MPV(a,b,c) __builtin_amdgcn_mfma_scale_f32_32x32x64_f8f6f4((a),(b),(c),1,0,0,0x7f7f7f7f,0,0x7f7f7f7f)
constexpr int NW=8,QBLK=32,QB=QBLK*NW,KVBLK=64;
__device__ __forceinline__ int crow(int r,int hi){return (r&3)+8*(r>>2)+4*hi;}
#define SBAR() __builtin_amdgcn_sched_barrier(0)

constexpr int NSLOT=3, SLOTB=8192;
constexpr int LDS_K=0, LDS_V=NSLOT*SLOTB, LDS_WS=2*NSLOT*SLOTB, LDS_OST=LDS_WS+NW*64*4, LDS_BYTES=LDS_OST+NW*4096;
constexpr float C2=0.125f*1.4426950408889634f;
__device__ __forceinline__ void glds16(const void*gsrc,unsigned lds_dst){unsigned keep;
  asm volatile("s_mov_b32 %0, m0\n\ts_mov_b32 m0, %2\n\ts_nop 0\n\tglobal_load_lds_dwordx4 %1, off\n\ts_mov_b32 m0, %0":"=&s"(keep):"v"(gsrc),"s"(lds_dst):"memory");}
__device__ __forceinline__ float max3f(float a,float b,float c){float r;asm("v_max3_f32 %0, %1, %2, %3":"=v"(r):"v"(a),"v"(b),"v"(c));return r;}
__device__ __forceinline__ float max2f(float a,float b){float r;asm("v_max_f32_e32 %0, %1, %2":"=v"(r):"v"(a),"v"(b));return r;}
__device__ __forceinline__ float fadd_s(float a,float b){float r;asm("v_add_f32_e32 %0, %1, %2":"=v"(r):"v"(a),"v"(b));return r;}
__device__ __forceinline__ float fsub_s(float a,float b){float r;asm("v_sub_f32_e32 %0, %1, %2":"=v"(r):"v"(a),"v"(b));return r;}
typedef float f32x2_t __attribute__((ext_vector_type(2))); typedef __bf16 bf16x2_t __attribute__((ext_vector_type(2))); typedef short s16x4 __attribute__((ext_vector_type(4)));
__device__ __forceinline__ unsigned cvtpk_s(float lo,float hi){f32x2_t v={lo,hi};bf16x2_t b=__builtin_convertvector(v,bf16x2_t);return __builtin_bit_cast(unsigned,b);}
#define WAIT_BAR(N) asm volatile("s_waitcnt vmcnt(" #N ") lgkmcnt(0)\n\ts_barrier":::"memory")

__device__ __forceinline__ void qkt(f32x16&p0,f32x16&p1,const char*Kslot,const i32x8*q8,const f32x16&negm,int r32,int hi){
  const int sw=(r32>>1)&7; const char*k0=Kslot+r32*128;
  #define KF_(kb_,p_) ({ const u32x4 a_=*reinterpret_cast<const u32x4*>(k0+(kb_)*4096+(((4*(p_)+2*hi)^sw)<<4)), b_=*reinterpret_cast<const u32x4*>(k0+(kb_)*4096+(((4*(p_)+2*hi+1)^sw)<<4)); \
      (i32x8){(int)a_.x,(int)a_.y,(int)a_.z,(int)a_.w,(int)b_.x,(int)b_.y,(int)b_.z,(int)b_.w}; })
  p0=M8(KF_(0,0),q8[0],negm); p1=M8(KF_(1,0),q8[0],negm); p0=M8(KF_(0,1),q8[1],p0); p1=M8(KF_(1,1),q8[1],p1);
  #undef KF_
}
typedef __attribute__((address_space(3))) const char* lds_cptr;
typedef short v4i16_t __attribute__((ext_vector_type(4)));
__device__ __forceinline__ i32x8 kfr(lds_cptr p0,lds_cptr p1){ const u32x4 a=*(const __attribute__((address_space(3))) u32x4*)p0, b=*(const __attribute__((address_space(3))) u32x4*)p1;
  return (i32x8){(int)a.x,(int)a.y,(int)a.z,(int)a.w,(int)b.x,(int)b.y,(int)b.z,(int)b.w}; }
__device__ __forceinline__ s16x4 vtr(lds_cptr p){ return __builtin_bit_cast(s16x4,__builtin_amdgcn_ds_read_tr16_b64_v4i16((__attribute__((address_space(3))) v4i16_t*)p)); }
__device__ __forceinline__ float rowmax(const f32x16&p0,const f32x16&p1){
  float a=max3f(p0[0],p0[1],p1[0]),b=max3f(p0[2],p0[3],p1[1]);a=max3f(a,p1[2],p1[3]);
  #pragma unroll
  for(int r=4;r<16;r+=4){a=max3f(a,p0[r],p0[r+1]);b=max3f(b,p0[r+2],p0[r+3]);a=max3f(a,p1[r],p1[r+1]);b=max3f(b,p1[r+2],p1[r+3]);}
  const float m=max2f(a,b);
  auto rr=__builtin_amdgcn_permlane32_swap(__float_as_uint(m),__float_as_uint(m),false,false);
  return max2f(__uint_as_float(rr[0]),__uint_as_float(rr[1]));
}
__device__ __forceinline__ void pv(f32x16*o,int vb,bf16x8 pa0,bf16x8 pa1,bf16x8 pa2,bf16x8 pa3){
  #pragma unroll
  for(int d0=0;d0<2;++d0){s16x4 lo[4],hi[4];
    #pragma unroll
    for(int ks=0;ks<4;++ks){
      asm volatile("ds_read_b64_tr_b16 %0,%1 offset:%c2":"=&v"(lo[ks]):"v"(vb),"i"(d0*4096+ks*1024):"memory");
      asm volatile("ds_read_b64_tr_b16 %0,%1 offset:%c2":"=&v"(hi[ks]):"v"(vb),"i"(d0*4096+ks*1024+512):"memory");}
    asm volatile("s_waitcnt lgkmcnt(0)":::"memory");SBAR();
    #define PK(k) (bf16x8){lo[k][0],lo[k][1],lo[k][2],lo[k][3],hi[k][0],hi[k][1],hi[k][2],hi[k][3]}
    o[d0]=__builtin_amdgcn_mfma_f32_32x32x16_bf16(pa0,PK(0),o[d0],0,0,0);
    o[d0]=__builtin_amdgcn_mfma_f32_32x32x16_bf16(pa1,PK(1),o[d0],0,0,0);
    o[d0]=__builtin_amdgcn_mfma_f32_32x32x16_bf16(pa2,PK(2),o[d0],0,0,0);
    o[d0]=__builtin_amdgcn_mfma_f32_32x32x16_bf16(pa3,PK(3),o[d0],0,0,0);
    #undef PK
  }
}

#ifndef ATTN_STORE16
#define ATTN_STORE16(p,v) (*(u32x4*)(p)=(v))
#endif

template<int THRL,int QP,int KP,int VP,int OP> __device__ __forceinline__ bool attn_unit(const unsigned char*Qu,const unsigned char*__restrict__ Kh,const unsigned char*__restrict__ Vh,bf16*Ou,const int NT,char*shm,const int wid,const float kmax,const bool allow_fix){
  const int lane=lane_id(),r32=lane&31,hi=lane>>5;
  const unsigned char*Qw=Qu+(long)wid*QBLK*QP;
  const unsigned lds0=(unsigned)(uintptr_t)shm;
  float*wsf=(float*)(shm+LDS_WS)+wid*64;
  const int kkey=wid*8+(lane>>3);
  const unsigned char*ksrc=Kh+(long)kkey*KP+(((lane&7)^((kkey>>1)&7))<<4);
  const unsigned char*vsrc=Vh+(wid&3)*1024+lane*16;
  const unsigned kdst=lds0+LDS_K+wid*1024, vdst=lds0+LDS_V+(wid&3)*1024;
  #define DMA_K(t,slot) glds16(ksrc+(long)(t)*KVBLK*KP,(unsigned)(kdst+(slot)))
  #define DMA_V(t,slot) glds16(vsrc+(long)(t)*4096,(unsigned)(vdst+(slot)))
  const char*Kbase=shm+LDS_K; i32x8 kf8[4];
  const lds_cptr shm3=(lds_cptr)shm; const int ksw=(r32>>1)&7; const lds_cptr kq00=shm3+LDS_K+r32*128+(((2*hi)^ksw)<<4), kq01=shm3+LDS_K+r32*128+(((2*hi+1)^ksw)<<4), kq10=shm3+LDS_K+r32*128+(((4+2*hi)^ksw)<<4), kq11=shm3+LDS_K+r32*128+(((5+2*hi)^ksw)<<4);
  #define KFRAG(j_,so_) (((j_)&1) ? kfr(kq10+(so_)+((j_)>>1)*4096,kq11+(so_)+((j_)>>1)*4096) : kfr(kq00+(so_)+((j_)>>1)*4096,kq01+(so_)+((j_)>>1)*4096))
  DMA_K(0,0);DMA_V(0,0);DMA_K(1,SLOTB);
  i32x8 q8[2]; q8[0]=*reinterpret_cast<const i32x8*>(Qw+(long)r32*QP+hi*32); q8[1]=*reinterpret_cast<const i32x8*>(Qw+(long)r32*QP+64+hi*32);
  float mhat=0.f;f32x16 o[2];o[0]=f32x16{};o[1]=f32x16{};f32x16 ls=f32x16{};f32x16 negm=f32x16{};
  bool fx=false; float POFF=7.0f;
  { float qn=0.f;
    _Pragma("unroll") for(int p=0;p<2;++p) _Pragma("unroll") for(int e=0;e<8;++e){ const int w_=q8[p][e]; const float a0=__builtin_amdgcn_cvt_f32_fp8(w_,0),a1=__builtin_amdgcn_cvt_f32_fp8(w_,1),a2=__builtin_amdgcn_cvt_f32_fp8(w_,2),a3=__builtin_amdgcn_cvt_f32_fp8(w_,3); qn+=(a0*a0+a1*a1)+(a2*a2+a3*a3); }
    { auto rr=__builtin_amdgcn_permlane32_swap(__float_as_uint(qn),__float_as_uint(qn),false,false); qn=__uint_as_float(rr[0])+__uint_as_float(rr[1]); }
    const float brow=sqrtf(qn)*0.125f*kmax*1.002f+0.05f;
    fx=allow_fix&&(kmax>0.f)&&!__any(!(brow<55.0f));
    POFF=fx?15.0f:7.0f;
    _Pragma("unroll") for(int r=0;r<16;++r)negm[r]=fx?(POFF-brow):POFF; }
  asm volatile("":"+v"(negm));
  i32x8 ones8={0x38383838,0x38383838,0x38383838,0x38383838,0x38383838,0x38383838,0x38383838,0x38383838}; asm volatile("":"+v"(ones8));
  const lds_cptr vpc0=shm3+LDS_V+r32*64+((((2*hi)^((r32>>2)&3)))<<4), vpc1=shm3+LDS_V+r32*64+((((2*hi+1)^((r32>>2)&3)))<<4);
  #define CMASK(P0,P1,t) do{}while(0)
  bool resc=false;
  #define START(P0,P1) do{ if(!fx){ const float rm=rowmax(P0,P1)-POFF; resc=false; \
    { const float dl=rm; mhat=fadd_s(mhat,dl); \
      _Pragma("unroll") for(int r=0;r<16;++r){P0[r]=fsub_s(P0[r],dl);P1[r]=fsub_s(P1[r],dl);} \
      _Pragma("unroll") for(int r=0;r<16;++r)negm[r]=POFF-mhat; asm volatile("":"+v"(negm)); } } \
    _Pragma("unroll") for(int r=0;r<16;++r)P0[r]=__builtin_amdgcn_exp2f(P0[r]); }while(0)
  #define RESC() do{ if(resc){ asm volatile("s_waitcnt lgkmcnt(0)":::"memory"); \
      _Pragma("unroll") for(int r=0;r<16;++r){ const float f_=wsf[crow(r,hi)]; o[0][r]*=f_; o[1][r]*=f_; ls[r]*=f_; } } }while(0)
  f32x16 pA0,pA1,pB0,pB1;
  int sl_prev=0,sl_cur=0,sl_next=SLOTB;
  #define ROT() do{sl_prev=sl_cur;sl_cur=sl_next;sl_next=(sl_next==(NSLOT-1)*SLOTB)?0:sl_next+SLOTB;}while(0)
  DMA_K(2,2*SLOTB);
  WAIT_BAR(3);
  qkt(pA0,pA1,Kbase,q8,negm,r32,hi);asm volatile("s_nop 15\n\ts_nop 7":"+v"(pA0),"+v"(pA1));CMASK(pA0,pA1,0);
  START(pA0,pA1);
  _Pragma("unroll") for(int r=0;r<16;++r)pA1[r]=__builtin_amdgcn_exp2f(pA1[r]);
  WAIT_BAR(0);
  DMA_K(3,0);DMA_V(1,SLOTB);
  ROT();
  kf8[0]=KFRAG(0,sl_cur); kf8[1]=KFRAG(1,sl_cur); kf8[2]=KFRAG(2,sl_cur); kf8[3]=KFRAG(3,sl_cur);
  WAIT_BAR(2);
  i32x8 pb=i32x8{}, vf0, vf1;
  #define PIN(x) asm volatile("":"+v"(x))
  #define MX3(a,b,c) __builtin_fmaxf(__builtin_fmaxf((a),(b)),(c))
  #define EX(v) __builtin_amdgcn_exp2f(v)
  #define PK8(P,B,OLD,HI) __builtin_amdgcn_cvt_pk_bf8_f32(P[B],P[(B)+1],OLD,HI)
  #define CV4(P,PB0,D0) do{ int x0_=pb[(D0)],x1_=pb[(D0)+1];        \
      x0_=PK8(P,(PB0),x0_,false); x0_=PK8(P,(PB0)+2,x0_,true); x1_=PK8(P,(PB0)+4,x1_,false); x1_=PK8(P,(PB0)+6,x1_,true); \
      pb[(D0)]=x0_; pb[(D0)+1]=x1_; }while(0)
  #define EX8(X,B) do{ X[(B)]=EX(X[(B)]); X[(B)+1]=EX(X[(B)+1]); X[(B)+2]=EX(X[(B)+2]); X[(B)+3]=EX(X[(B)+3]); X[(B)+4]=EX(X[(B)+4]); X[(B)+5]=EX(X[(B)+5]); X[(B)+6]=EX(X[(B)+6]); X[(B)+7]=EX(X[(B)+7]); PIN(X); }while(0)
  #define KRD(G,j) do{ if(G){ kf8[j]=KFRAG(j,sl_next); SBAR(); } }while(0)
  #define STEP(C0,C1,P0,P1,t,GK,GV,GL) do{ SBAR(); \
    vf0=kfr(vpc0+sl_prev,vpc1+sl_prev); vf1=kfr(vpc0+sl_prev+2048,vpc1+sl_prev+2048); SBAR(); \
    C0=M8(kf8[0],q8[0],negm); CV4(P0,0,0); PIN(pb); SBAR(); \
    C1=M8(kf8[2],q8[0],negm); CV4(P0,8,2); PIN(pb); SBAR(); \
    C0=M8(kf8[1],q8[1],C0);   CV4(P1,0,4); PIN(pb); SBAR(); \
    C1=M8(kf8[3],q8[1],C1);   CV4(P1,8,6); PIN(pb); SBAR(); \
    if(GK){DMA_K((t)+3,sl_cur);} if(GV){DMA_V((t)+1,sl_next);} \
    CMASK(C0,C1,t); \
    if(!fx){ float a=MX3(C0[0],C0[1],C1[0]),b=MX3(C0[2],C0[3],C1[1]); a=MX3(a,C1[2],C1[3]); \
      _Pragma("unroll") for(int r=4;r<16;r+=4){a=MX3(a,C0[r],C0[r+1]);b=MX3(b,C0[r+2],C0[r+3]);a=MX3(a,C1[r],C1[r+1]);b=MX3(b,C1[r+2],C1[r+3]);} \
      float rm=__builtin_fmaxf(a,b); { auto rr=__builtin_amdgcn_permlane32_swap(__float_as_uint(rm),__float_as_uint(rm),false,false); rm=__builtin_fmaxf(__uint_as_float(rr[0]),__uint_as_float(rr[1])); } \
      rm-=POFF; resc=false; \
      if(__builtin_expect(__any(rm>(float)THRL),0)){ const float dl=__builtin_fmaxf(rm,0.f); mhat+=dl; \
        _Pragma("unroll") for(int r=0;r<16;++r){C0[r]-=dl;C1[r]-=dl;} \
        _Pragma("unroll") for(int r=0;r<16;++r)negm[r]=POFF-mhat; asm volatile("":"+v"(negm)); \
        const float f=__builtin_amdgcn_exp2f(-dl); if(hi==0)wsf[r32]=f; resc=true; } } \
    SBAR(); \
    o[0]=MPV(pb,vf0,o[0]); EX8(C0,0); SBAR(); \
    KRD(GL,0); KRD(GL,1); o[1]=MPV(pb,vf1,o[1]); EX8(C0,8); SBAR(); \
    KRD(GL,2); KRD(GL,3); ls=MPV(pb,ones8,ls); EX8(C1,0); SBAR(); \
    EX8(C1,8); SBAR(); \
    }while(0)
  if(wid>=4)__builtin_amdgcn_s_setprio(1);
  int t=1;
  for(;t+5<NT;t+=2){
    STEP(pB0,pB1,pA0,pA1,t,true,true,true);     WAIT_BAR(2); RESC(); ROT();
    STEP(pA0,pA1,pB0,pB1,t+1,true,true,true);   WAIT_BAR(2); RESC(); ROT();
  }
  #define ENDW(tt) do{ if((tt)+3<NT){WAIT_BAR(2);} else if((tt)+2<NT){WAIT_BAR(1);} else {WAIT_BAR(0);} }while(0)
  for(;t+1<NT;t+=2){
    STEP(pB0,pB1,pA0,pA1,t,(t+3<NT),(t+1<NT),(t+1<NT));       ENDW(t);   RESC(); ROT();
    STEP(pA0,pA1,pB0,pB1,t+1,(t+4<NT),(t+2<NT),(t+2<NT));     ENDW(t+1); RESC(); ROT();
  }
  STEP(pB0,pB1,pA0,pA1,NT-1,false,false,false); RESC();
  { CV4(pB0,0,0); CV4(pB0,8,2); CV4(pB1,0,4); CV4(pB1,8,6); PIN(pb); SBAR();
    vf0=kfr(vpc0+sl_cur,vpc1+sl_cur); vf1=kfr(vpc0+sl_cur+2048,vpc1+sl_cur+2048);
    o[0]=MPV(pb,vf0,o[0]); o[1]=MPV(pb,vf1,o[1]); ls=MPV(pb,ones8,ls); }
  #undef PIN
  #undef MX3
  #undef EX
  #undef PK8
  #undef CV4
  #undef EX8
  #undef KRD
  #undef KFRAG
  #undef STEP
  #undef ENDW
  __builtin_amdgcn_s_setprio(0);
  float rli[16]; float lmin=ls[0];
  #pragma unroll
  for(int r=0;r<16;++r){ rli[r]=__builtin_amdgcn_rcpf(ls[r]); lmin=__builtin_fminf(lmin,ls[r]); }
  const bool sunk=fx&&__any(!(lmin>=1.0f));
  bf16*Ow=Ou+(long)wid*QBLK*OP;
  { bf16*stg=(bf16*)(shm+LDS_OST)+wid*2048;
    #pragma unroll
    for(int r=0;r<16;++r){const int orow=crow(r,hi);
      #pragma unroll
      for(int d0=0;d0<2;++d0)stg[orow*64+d0*32+r32]=(bf16)f2bf(o[d0][r]*rli[r]);}
    asm volatile("s_waitcnt lgkmcnt(0)":::"memory");
    #pragma unroll
    for(int i=0;i<4;++i){const int row=i*8+(lane>>3),ch=lane&7; const u32x4 v=*(const u32x4*)(stg+row*64+ch*8); ATTN_STORE16(Ow+(long)row*OP+ch*8,v);} }
  asm volatile("s_waitcnt lgkmcnt(0)\n\ts_barrier":::"memory");
  #undef DMA_K
  #undef DMA_V
  #undef CMASK
  #undef START
  #undef RESC
  #undef ROT
  return sunk;
}

#undef SBAR
#undef WAIT_BAR
constexpr int ATTN_LDS_BYTES=LDS_BYTES;
#undef M8
}


constexpr size_t MiB = 1u << 20;
constexpr size_t WS_CTL = 0, CTL_ZERO_BYTES = 1 * MiB;
constexpr size_t WS_MODS = 1 * MiB;
constexpr size_t WS_ROPE = WS_MODS + 256 * 1024;
constexpr size_t WS_PARAMS = WS_MODS + 320 * 1024;
constexpr int P_LN1G = 0, P_LN1B = 2048, P_LN2G = 4096, P_LN2B = 6144, P_QG = 8192, P_KG = 8256, P_WPOOL = 8320, P_PSC = 24704, P_QLG = 24960, P_KVLG = 25344, P_NAB = 25600, P_WR = 29440, P_BR = 37632, P_END = 37696;
static_assert(WS_PARAMS + (size_t)P_END * 4 <= WS_MODS + 512 * 1024, "params block");
constexpr size_t WS_X1C = WS_MODS + 512 * 1024;
constexpr size_t WS_ROUTE = 4 * MiB;
constexpr size_t WS_W0IN = 5 * MiB, WS_W0OUT = 8 * MiB, WS_W0GU = 10 * MiB, WS_W0D = 21 * MiB, WS_W1IN = 27 * MiB, WS_W1OUT = 32 * MiB, WS_WQ = 34 * MiB, WS_WKV = 35 * MiB;
constexpr size_t WS_SA = 36 * MiB;
constexpr size_t WS_H0 = WS_SA, WS_Q0 = WS_SA + 98 * MiB, WS_ACT0 = WS_SA, WS_H1RAW = WS_SA, WS_WEGU = WS_SA, WS_WED = WS_SA + 112 * MiB;
constexpr size_t WS_SB = 216 * MiB;
constexpr size_t WS_SC = 282 * MiB;
constexpr size_t WS_K0 = WS_SC, WS_V0 = WS_SC + 17 * MiB, WS_MIX0 = WS_SC + 34 * MiB, WS_Y0 = WS_SC + 100 * MiB, WS_U1 = WS_SC + 100 * MiB;
constexpr size_t WS_K1 = WS_SC, WS_Q1B = WS_SC + 33 * MiB, WS_V1 = WS_SC + 66 * MiB, WS_MIX1 = WS_SC + 100 * MiB, WS_H3 = WS_SC + 100 * MiB;
constexpr size_t WS_W8GU = WS_SA, WS_W8D = WS_SA + 56 * MiB, WS_XPAD = 120 * MiB, WS_ACT = 186 * MiB, WS_YPAD = 298 * MiB;
constexpr size_t WS_SCL = 464 * MiB, WS_SA_ROW = WS_SCL, WS_SA_SLOT = WS_SCL + 512 * 1024, WS_SW_0GU = WS_SCL + 1024 * 1024, WS_SW_0IN = WS_SW_0GU + 32 * 1024, WS_SW_1IN = WS_SW_0GU + 48 * 1024, WS_SW_EGU = WS_SCL + 1280 * 1024;
constexpr size_t WS_END = 466 * MiB;
static_assert(WS_H0 + (size_t)MA * N_IN0 * 2 <= WS_Q0 && WS_Q0 + (size_t)MA * 768 * 2 <= WS_SB, "SA layer-0 map");
static_assert(WS_ACT0 + (size_t)MA * FF0 * 2 <= WS_SB && WS_H1RAW + (size_t)MA * N_IN1 * 2 <= WS_SB, "SA map");
static_assert(WS_WEGU + (size_t)NEXP * 2 * FFE * DM * 2 <= WS_WED && WS_WED + (size_t)NEXP * DM * FFE * 2 <= WS_SB, "MoE weights map");
static_assert(WS_SB + (size_t)MA * DM * 2 <= WS_SC, "SB map");
static_assert(WS_K0 + (size_t)2 * NKEY * 256 * 2 <= WS_V0 && WS_V0 + (size_t)2 * NKEY * 256 * 2 <= WS_MIX0 && WS_MIX0 + (size_t)MA * DM * 2 <= WS_Y0, "SC layer-0 map");
static_assert(WS_K1 + (size_t)2 * NKEY * 1024 <= WS_Q1B && WS_Q1B + (size_t)MS * 1024 <= WS_V1 && WS_V1 + (size_t)2 * NKEY * 512 * 2 <= WS_MIX1, "SC layer-1 map");
static_assert(WS_W8GU + (size_t)NEXP * 2 * FFE * DM <= WS_W8D && WS_W8D + (size_t)NEXP * DM * FFE <= WS_XPAD && WS_XPAD + (size_t)MOE_TILES * 256 * DM <= WS_ACT && WS_ACT + (size_t)MOE_CHUNK_TILES * 256 * FFE <= WS_YPAD && WS_YPAD + (size_t)MOE_TILES * 256 * DM * 2 <= WS_SCL && WS_Y0 + (size_t)MA * DM * 2 <= WS_END, "MoE map");
static_assert(WS_W0IN + (size_t)N_IN0 * DM * 2 <= WS_W0OUT && WS_W0GU + (size_t)2 * FF0 * DM * 2 <= WS_W0D && WS_W0D + (size_t)DM * FF0 * 2 <= WS_W1IN && WS_W1IN + (size_t)N_IN1 * DM * 2 <= WS_W1OUT && WS_WKV + (size_t)1024 * 256 * 2 <= WS_SA, "weights map");
constexpr int CW_TMO = 0;
constexpr int CW_BAR = 4096;
constexpr int CW_KMAX = 8192;
constexpr int CW_CNT = 16384, CW_CUR = 16384 + 1024;

constexpr int RING_BYTES = 131072, LDSCTL_OFF = RING_BYTES, MISC_OFF = LDSCTL_OFF + 320, LDS_BYTES = 147456;
static_assert(att::L_END <= RING_BYTES && att64q8::ATTN_LDS_BYTES <= RING_BYTES && att96q8::ATTN_LDS_BYTES <= RING_BYTES, "attention LDS");

#define XB_TMO      128
#define XB_XCNT(j)  (256  + 64 * (j))
#define XB_XSUB(j)  (1280 + 64 * (j))
#define XB_XGEN(j)  (2304 + 64 * (j))
#define XB_TOP      3328
#define XB_TOPGEN   3392
#define XCD_BAR_WORDS 3456
#define XB_SPIN_CAP (1u << 18)
__device__ __forceinline__ unsigned xb_ld(unsigned* p)              { return __hip_atomic_load(p, __ATOMIC_RELAXED, __HIP_MEMORY_SCOPE_AGENT); }
__device__ __forceinline__ unsigned xb_add(unsigned* p, unsigned v) { return __hip_atomic_fetch_add(p, v, __ATOMIC_RELAXED, __HIP_MEMORY_SCOPE_AGENT); }
__device__ __forceinline__ unsigned xb_xcc_id() { return (unsigned)__builtin_amdgcn_s_getreg((3 << 11) | 20) & 0xFu; }
#define XB_SPIN(cond, bar) do { unsigned _sp = 0; while (cond) { __builtin_amdgcn_s_sleep(1); \
    if ((++_sp & 255u) == 0u) { if (xb_ld(&(bar)[XB_TMO])) break; if (_sp > XB_SPIN_CAP) { atomicAdd(&(bar)[XB_TMO], 1u); break; } } } } while (0)
struct XcdBarrier { unsigned* bar; unsigned x; volatile LAS unsigned* st; };
__device__ __forceinline__ XcdBarrier xcd_barrier_post(unsigned* bar, volatile LAS unsigned* st) {
    XcdBarrier b; b.bar = bar; b.x = xb_xcc_id(); b.st = st;
    if (threadIdx.x == 0) (void)xb_add(&bar[XB_XCNT(b.x)], 1u);
    return b;
}
__device__ __forceinline__ void xcd_barrier_complete(unsigned* bar, unsigned x, unsigned& nloc, unsigned& nx) {
    const unsigned G = gridDim.x * gridDim.y * gridDim.z;
    unsigned sum, cnt, mine, sp = 0u;
    for (;;) {
        sum = 0u; cnt = 0u; mine = 0u;
#pragma unroll
        for (unsigned j = 0; j < 16; ++j) { const unsigned c = xb_ld(&bar[XB_XCNT(j)]); sum += c; cnt += (c > 0u) ? 1u : 0u; mine = (j == x) ? c : mine; }
        if (sum == G) break;
        __builtin_amdgcn_s_sleep(1);
        if ((++sp & 255u) == 0u) { if (xb_ld(&bar[XB_TMO])) break; if (sp > XB_SPIN_CAP) { atomicAdd(&bar[XB_TMO], 1u); break; } }
    }
    nloc = mine > 0u ? mine : 1u; nx = cnt > 0u ? cnt : 1u;
}
__device__ __forceinline__ void xcd_barrier(const XcdBarrier& b) {
    asm volatile("s_waitcnt vmcnt(0)" ::: "memory");
    __syncthreads();
    if (threadIdx.x == 0) {
        unsigned* bar = b.bar;
        __builtin_amdgcn_s_waitcnt(0);
        unsigned nloc = b.st[0], nx = b.st[1];
        if (nloc == 0u) { xcd_barrier_complete(bar, b.x, nloc, nx); b.st[0] = nloc; b.st[1] = nx; }
        const unsigned old = xb_add(&bar[XB_XSUB(b.x)], 1u);
        const unsigned gen = old / nloc;
        if (old + 1u == (gen + 1u) * nloc) {
            __builtin_amdgcn_fence(__ATOMIC_RELEASE, "agent");
            asm volatile("s_waitcnt vmcnt(0)" ::: "memory");
            const unsigned og = xb_add(&bar[XB_TOP], 1u);
            const unsigned tg = og / nx;
            if (og + 1u == (tg + 1u) * nx) xb_add(&bar[XB_TOPGEN], 1u);
            else XB_SPIN(xb_ld(&bar[XB_TOPGEN]) == tg, bar);
            __builtin_amdgcn_fence(__ATOMIC_ACQUIRE, "agent");
            xb_add(&bar[XB_XGEN(b.x)], 1u);
            asm volatile("s_waitcnt vmcnt(0)" ::: "memory");
        } else {
            XB_SPIN(xb_ld(&bar[XB_XGEN(b.x)]) == gen, bar);
            __builtin_amdgcn_fence(__ATOMIC_ACQUIRE, "agent");
            asm volatile("s_waitcnt vmcnt(0)" ::: "memory");
        }
    }
    __syncthreads();
}

__device__ __forceinline__ void cvt_item(const float* src, int ldsrc, int scol0, int k0, bf16* dst, int K, int drow0, float scale, LAS float* scr, int lane) {
    const int kr = lane >> 3, c4 = lane & 7;
    f32x4 v[8];
#pragma unroll
    for (int i = 0; i < 8; ++i) v[i] = src ? *(const f32x4*)(src + (size_t)(k0 + 8 * i + kr) * ldsrc + scol0 + 4 * c4) : (f32x4){0.f, 0.f, 0.f, 0.f};
#pragma unroll
    for (int i = 0; i < 8; ++i) { LAS float* p = scr + (8 * i + kr) * 33 + 4 * c4; p[0] = v[i][0] * scale; p[1] = v[i][1] * scale; p[2] = v[i][2] * scale; p[3] = v[i][3] * scale; }
    LDS_WAIT(); asm volatile("" ::: "memory");
    const int c = lane & 7;
#pragma unroll
    for (int j = 0; j < 4; ++j) { const int n = (lane >> 3) + 8 * j; const LAS float* sp = scr + (8 * c) * 33 + n;
        u32x4 o; o.x = pk2(sp[0 * 33], sp[1 * 33]); o.y = pk2(sp[2 * 33], sp[3 * 33]); o.z = pk2(sp[4 * 33], sp[5 * 33]); o.w = pk2(sp[6 * 33], sp[7 * 33]);
        *(u32x4*)(dst + (size_t)(drow0 + n) * K + k0 + 8 * c) = o; }
    LDS_WAIT(); asm volatile("" ::: "memory");
}
__device__ __forceinline__ void cvt_item8(const float* src, int ldsrc, int scol0, int k0, unsigned char* dst, int K, int drow0, float scale, LAS float* scr, int lane) {
    const int kr = lane >> 3, c4 = lane & 7;
    f32x4 v[8];
#pragma unroll
    for (int i = 0; i < 8; ++i) v[i] = *(const f32x4*)(src + (size_t)(k0 + 8 * i + kr) * ldsrc + scol0 + 4 * c4);
#pragma unroll
    for (int i = 0; i < 8; ++i) { LAS float* p = scr + (8 * i + kr) * 33 + 4 * c4; p[0] = v[i][0] * scale; p[1] = v[i][1] * scale; p[2] = v[i][2] * scale; p[3] = v[i][3] * scale; }
    LDS_WAIT(); asm volatile("" ::: "memory");
    const int c = lane & 7;
#pragma unroll
    for (int j = 0; j < 4; ++j) { const int n = (lane >> 3) + 8 * j; const LAS float* sp = scr + (8 * c) * 33 + n;
        int w0 = 0, w1 = 0; w0 = __builtin_amdgcn_cvt_pk_fp8_f32(sp[0 * 33], sp[1 * 33], w0, false); w0 = __builtin_amdgcn_cvt_pk_fp8_f32(sp[2 * 33], sp[3 * 33], w0, true);
        w1 = __builtin_amdgcn_cvt_pk_fp8_f32(sp[4 * 33], sp[5 * 33], w1, false); w1 = __builtin_amdgcn_cvt_pk_fp8_f32(sp[6 * 33], sp[7 * 33], w1, true);
        u32x2 o; o.x = (unsigned)w0; o.y = (unsigned)w1; *(u32x2*)(dst + (size_t)(drow0 + n) * K + k0 + 8 * c) = o; }
    LDS_WAIT(); asm volatile("" ::: "memory");
}
__device__ __forceinline__ unsigned pk_i8(float a, float b, float c, float d) {
    const int q0 = (int)__builtin_rintf(a), q1 = (int)__builtin_rintf(b), q2 = (int)__builtin_rintf(c), q3 = (int)__builtin_rintf(d);
    return (unsigned)(q0 & 255) | ((unsigned)(q1 & 255) << 8) | ((unsigned)(q2 & 255) << 16) | ((unsigned)q3 << 24); }
__device__ __forceinline__ void cvt_strip_i8(const float* src, int ldsrc, int scol0, int K, unsigned char* dst, int drow0, float* sw, float wscale, LAS float* scr, int lane) {
    const int kr = lane >> 3, c4 = lane & 7;
    if (!src) {
        for (int k0 = 0; k0 < K; k0 += 64) {
#pragma unroll
            for (int j = 0; j < 4; ++j) *(u32x2*)(dst + (size_t)(drow0 + (lane >> 3) + 8 * j) * K + k0 + 8 * (lane & 7)) = (u32x2){0u, 0u}; }
        if (kr == 0) *(f32x4*)(sw + drow0 + 4 * c4) = (f32x4){0.f, 0.f, 0.f, 0.f};
        return; }
    f32x4 mx = {0.f, 0.f, 0.f, 0.f};
#pragma unroll 2
    for (int k0 = 0; k0 < K; k0 += 64) {
        f32x4 v[8];
#pragma unroll
        for (int i = 0; i < 8; ++i) v[i] = *(const f32x4*)(src + (size_t)(k0 + 8 * i + kr) * ldsrc + scol0 + 4 * c4);
#pragma unroll
        for (int i = 0; i < 8; ++i) { mx[0] = fmaxf(mx[0], fabsf(v[i][0])); mx[1] = fmaxf(mx[1], fabsf(v[i][1])); mx[2] = fmaxf(mx[2], fabsf(v[i][2])); mx[3] = fmaxf(mx[3], fabsf(v[i][3])); }
    }
#pragma unroll
    for (int o = 8; o < 64; o <<= 1) { mx[0] = fmaxf(mx[0], shx(mx[0], o)); mx[1] = fmaxf(mx[1], shx(mx[1], o)); mx[2] = fmaxf(mx[2], shx(mx[2], o)); mx[3] = fmaxf(mx[3], shx(mx[3], o)); }
    f32x4 inv;
#pragma unroll
    for (int j = 0; j < 4; ++j) inv[j] = mx[j] > 0.f ? 127.0f / mx[j] : 0.f;
    if (kr == 0) *(f32x4*)(sw + drow0 + 4 * c4) = mx * (wscale / 127.0f);
#pragma unroll 1
    for (int k0 = 0; k0 < K; k0 += 64) {
        f32x4 v[8];
#pragma unroll
        for (int i = 0; i < 8; ++i) v[i] = *(const f32x4*)(src + (size_t)(k0 + 8 * i + kr) * ldsrc + scol0 + 4 * c4);
#pragma unroll
        for (int i = 0; i < 8; ++i) { LAS float* p = scr + (8 * i + kr) * 33 + 4 * c4; p[0] = v[i][0] * inv[0]; p[1] = v[i][1] * inv[1]; p[2] = v[i][2] * inv[2]; p[3] = v[i][3] * inv[3]; }
        LDS_WAIT(); asm volatile("" ::: "memory");
        const int c = lane & 7;
#pragma unroll
        for (int j = 0; j < 4; ++j) { const int n = (lane >> 3) + 8 * j; const LAS float* sp = scr + (8 * c) * 33 + n;
            u32x2 o; o.x = pk_i8(sp[0 * 33], sp[1 * 33], sp[2 * 33], sp[3 * 33]); o.y = pk_i8(sp[4 * 33], sp[5 * 33], sp[6 * 33], sp[7 * 33]);
            *(u32x2*)(dst + (size_t)(drow0 + n) * K + k0 + 8 * c) = o; }
        LDS_WAIT(); asm volatile("" ::: "memory");
    }
}
__device__ __forceinline__ void build_vt_images(const bf16* V, int vpitch, int nheads, unsigned char* out, int gw_, int ngw_, LAS unsigned char* img, int lane) {
    const int k5 = lane & 31, g_ = (k5 >> 2) & 1, pos = g_ * 32 + (k5 & 3) + 4 * (k5 >> 3) + 16 * (lane >> 5), ch = pos >> 4, by = pos & 15;
    for (int it = gw_; it < 2 * nheads * (NKEY / 64); it += ngw_) {
        const int bk = it / (NKEY / 64), t = it - bk * (NKEY / 64); const int b = bk / nheads, hd = bk - b * nheads;
        const bf16* src = V + (size_t)(b * NKEY + t * 64 + lane) * vpitch + hd * 64;
        u32x4 v[8];
#pragma unroll
        for (int i = 0; i < 8; ++i) v[i] = *(const u32x4*)(src + 8 * i);
#pragma unroll
        for (int i = 0; i < 8; ++i) {
#pragma unroll
            for (int j = 0; j < 4; ++j) { const unsigned w = j == 0 ? v[i].x : j == 1 ? v[i].y : j == 2 ? v[i].z : v[i].w; const int d = 8 * i + 2 * j;
                const int p8 = __builtin_amdgcn_cvt_pk_fp8_f32(__uint_as_float(w << 16), __uint_as_float(w & 0xffff0000u), 0, false);
                LAS unsigned char* q = img + ((ch ^ ((d >> 2) & 3)) << 4) + by;
                q[d * 64] = (unsigned char)(p8 & 255); q[(d + 1) * 64] = (unsigned char)((p8 >> 8) & 255); } }
        LDS_WAIT(); asm volatile("" ::: "memory");
        unsigned char* dst = out + (size_t)it * 4096 + lane * 64;
#pragma unroll
        for (int i = 0; i < 4; ++i) *(u32x4*)(dst + 16 * i) = *(const LAS u32x4*)(img + lane * 64 + 16 * i);
        LDS_WAIT(); asm volatile("" ::: "memory");
    }
}
struct Row16 { f32x4 v[4]; };
__device__ __forceinline__ Row16 ld_row_f32(const float* p, int lane) { Row16 r; const f32x4* q = (const f32x4*)p + lane;
#pragma unroll
    for (int j = 0; j < 4; ++j) r.v[j] = q[64 * j];
    return r; }
__device__ __forceinline__ Row16 ld_row_bf16(const bf16* p, int lane) { Row16 r; const u32x2* q = (const u32x2*)p + lane;
#pragma unroll
    for (int j = 0; j < 4; ++j) { const u32x2 w = q[64 * j]; r.v[j] = (f32x4){__uint_as_float(w.x << 16), __uint_as_float(w.x & 0xffff0000u), __uint_as_float(w.y << 16), __uint_as_float(w.y & 0xffff0000u)}; }
    return r; }
__device__ __forceinline__ void st_row_f32(float* p, int lane, const Row16& r) { f32x4* q = (f32x4*)p + lane;
#pragma unroll
    for (int j = 0; j < 4; ++j) __builtin_nontemporal_store(r.v[j], q + 64 * j); }
__device__ __forceinline__ void st_row_bf16(bf16* p, int lane, const Row16& r) { u32x2* q = (u32x2*)p + lane;
#pragma unroll
    for (int j = 0; j < 4; ++j) { u32x2 w; w.x = pk2(r.v[j][0], r.v[j][1]); w.y = pk2(r.v[j][2], r.v[j][3]); q[64 * j] = w; } }
__device__ __forceinline__ void st_row_i8(unsigned char* p, float* sa, int lane, const Row16& r) { unsigned* q = (unsigned*)p + lane;
    float am = 0.f;
#pragma unroll
    for (int j = 0; j < 4; ++j) am = fmaxf(fmaxf(am, fmaxf(fabsf(r.v[j][0]), fabsf(r.v[j][1]))), fmaxf(fabsf(r.v[j][2]), fabsf(r.v[j][3])));
    am = wave_max(am); const float inv = am > 0.f ? 127.0f / am : 0.f;
    if (lane == 0) *sa = am * (1.0f / 127.0f);
#pragma unroll
    for (int j = 0; j < 4; ++j) q[64 * j] = pk_i8(r.v[j][0] * inv, r.v[j][1] * inv, r.v[j][2] * inv, r.v[j][3] * inv); }
__device__ __forceinline__ void st_row_fp8(unsigned char* p, int lane, const Row16& r, float sc) { unsigned* q = (unsigned*)p + lane;
#pragma unroll
    for (int j = 0; j < 4; ++j) { int w_ = 0; w_ = __builtin_amdgcn_cvt_pk_fp8_f32(r.v[j][0] * sc, r.v[j][1] * sc, w_, false); w_ = __builtin_amdgcn_cvt_pk_fp8_f32(r.v[j][2] * sc, r.v[j][3] * sc, w_, true); q[64 * j] = (unsigned)w_; } }
__device__ __forceinline__ void ln_row(Row16& z, const float* g, const float* b, int lane) {
    float s = 0.f;
#pragma unroll
    for (int j = 0; j < 4; ++j) s += (z.v[j][0] + z.v[j][1]) + (z.v[j][2] + z.v[j][3]);
    const float mean = wave_sum(s) * (1.f / DM); float s2 = 0.f;
#pragma unroll
    for (int j = 0; j < 4; ++j) { z.v[j] = z.v[j] - mean; s2 += (z.v[j][0] * z.v[j][0] + z.v[j][1] * z.v[j][1]) + (z.v[j][2] * z.v[j][2] + z.v[j][3] * z.v[j][3]); }
    const float rstd = 1.0f / sqrtf(wave_sum(s2) * (1.f / DM) + EPS);
    const Row16 gg = ld_row_f32(g, lane), bb = ld_row_f32(b, lane);
#pragma unroll
    for (int j = 0; j < 4; ++j) z.v[j] = z.v[j] * rstd * gg.v[j] + bb.v[j];
}
__device__ __forceinline__ void ln_row2(Row16& z, const Row16& gg, const Row16& bb) {
    float s = 0.f;
#pragma unroll
    for (int j = 0; j < 4; ++j) s += (z.v[j][0] + z.v[j][1]) + (z.v[j][2] + z.v[j][3]);
    const float mean = wave_sum(s) * (1.f / DM); float s2 = 0.f;
#pragma unroll
    for (int j = 0; j < 4; ++j) { z.v[j] = z.v[j] - mean; s2 += (z.v[j][0] * z.v[j][0] + z.v[j][1] * z.v[j][1]) + (z.v[j][2] * z.v[j][2] + z.v[j][3] * z.v[j][3]); }
    const float rstd = 1.0f / sqrtf(wave_sum(s2) * (1.f / DM) + EPS);
#pragma unroll
    for (int j = 0; j < 4; ++j) z.v[j] = z.v[j] * rstd * gg.v[j] + bb.v[j];
}
struct RowIn { f32x4 x[4]; u32x2 y[4]; };
__device__ __forceinline__ RowIn ld_rowin(const float* xp, const bf16* yp, int lane) { RowIn r; const f32x4* q = (const f32x4*)xp + lane; const u32x2* p = (const u32x2*)yp + lane;
#pragma unroll
    for (int j = 0; j < 4; ++j) { r.x[j] = q[64 * j]; r.y[j] = p[64 * j]; }
    return r; }
__device__ __forceinline__ void ald_rowin(RowIn& r, const float* xp, const bf16* yp, int lane) { const f32x4* q = (const f32x4*)xp + lane; const u32x2* p = (const u32x2*)yp + lane;
    asm volatile("global_load_dwordx4 %0, %4, off\n\tglobal_load_dwordx4 %1, %4, off offset:1024\n\tglobal_load_dwordx4 %2, %4, off offset:2048\n\tglobal_load_dwordx4 %3, %4, off offset:3072"
                 : "=&v"(r.x[0]), "=&v"(r.x[1]), "=&v"(r.x[2]), "=&v"(r.x[3]) : "v"(q) : "memory");
    asm volatile("global_load_dwordx2 %0, %4, off\n\tglobal_load_dwordx2 %1, %4, off offset:512\n\tglobal_load_dwordx2 %2, %4, off offset:1024\n\tglobal_load_dwordx2 %3, %4, off offset:1536"
                 : "=&v"(r.y[0]), "=&v"(r.y[1]), "=&v"(r.y[2]), "=&v"(r.y[3]) : "v"(p) : "memory"); }
__device__ __forceinline__ void ald_row16(Row16& r, const float* xp, int lane) { const f32x4* q = (const f32x4*)xp + lane;
    asm volatile("global_load_dwordx4 %0, %4, off\n\tglobal_load_dwordx4 %1, %4, off offset:1024\n\tglobal_load_dwordx4 %2, %4, off offset:2048\n\tglobal_load_dwordx4 %3, %4, off offset:3072"
                 : "=&v"(r.v[0]), "=&v"(r.v[1]), "=&v"(r.v[2]), "=&v"(r.v[3]) : "v"(q) : "memory"); }
#define ROW16_WAIT(N, r) asm volatile("s_waitcnt vmcnt(" #N ")" : "+v"(r.v[0]), "+v"(r.v[1]), "+v"(r.v[2]), "+v"(r.v[3]) :: "memory")
#define ROW_WAIT(N, r) asm volatile("s_waitcnt vmcnt(" #N ")" : "+v"(r.x[0]), "+v"(r.x[1]), "+v"(r.x[2]), "+v"(r.x[3]), "+v"(r.y[0]), "+v"(r.y[1]), "+v"(r.y[2]), "+v"(r.y[3]) :: "memory")
__device__ __forceinline__ f32x4 bf4(const u32x2 w) { return (f32x4){__uint_as_float(w.x << 16), __uint_as_float(w.x & 0xffff0000u), __uint_as_float(w.y << 16), __uint_as_float(w.y & 0xffff0000u)}; }
__device__ __forceinline__ Row16 modulate(const Row16& x, const float* shift, const float* scale, int lane) {
    const Row16 sh = ld_row_f32(shift, lane), sc = ld_row_f32(scale, lane); Row16 r;
#pragma unroll
    for (int j = 0; j < 4; ++j) r.v[j] = x.v[j] * (1.0f + sc.v[j]) + sh.v[j];
    return r;
}

enum { I_X = 0, I_C, I_CTX, I_CCTX, I_WADA, I_BADA, I_LN1G, I_LN1B, I_LN2G, I_LN2B, I_EVWIN, I_EVWOUT, I_EVQG, I_EVKG, I_EVWPOOL, I_EVPSCALE, I_EVWG, I_EVWU, I_EVWD,
       I_ODWIN, I_ODWOUT, I_ODQLG, I_ODKVLG, I_ODWQUP, I_ODWKVUP, I_ODNABIAS, I_ODWR, I_ODBR, I_ODWG, I_ODWU, I_ODWD, N_INPUTS };
constexpr int N_PHASES = 29;
struct Args { const float* in[N_INPUTS]; float* out; unsigned char* ws; int ph_lo, ph_hi; };

__global__ void __launch_bounds__(512, 2) fwd_kernel(Args args) {
    extern __shared__ __attribute__((aligned(16))) unsigned char lds_raw[];
    LAS unsigned char* lds = (LAS unsigned char*)lds_raw;
    volatile LAS unsigned* MISC = (volatile LAS unsigned*)(lds + MISC_OFF);
    const int wave = __builtin_amdgcn_readfirstlane((int)threadIdx.x >> 6);
#define G ((int)gridDim.x)
#define bx ((int)blockIdx.x)
#define vcu ((bx % 8) * (G / 8) + bx / 8)
#define gw (vcu * 8 + wave)
#define NGW (G * 8)
    unsigned char* ws = args.ws;
    gu32* ctl = (gu32*)(ws + WS_CTL);
    for (int u = wave * 64 + lane_id(); u < (LDS_BYTES - LDSCTL_OFF) / 4; u += 512) ((LAS unsigned*)(lds + LDSCTL_OFF))[u] = 0u;
    __syncthreads();
    if (!MK_PER_PHASE) (void)xcd_barrier_post((unsigned*)(ctl + CW_BAR), MISC + 8);
#define BAR_NOW() XcdBarrier{(unsigned*)((gu32*)(args.ws + WS_CTL) + CW_BAR), xb_xcc_id(), (volatile LAS unsigned*)(lds + MISC_OFF) + 8}
#if MK_PER_PHASE || PROBE_K > 0
    const int lo = args.ph_lo, hi = args.ph_hi;
#else
    constexpr int lo = 0, hi = N_PHASES + 1;
#endif
#define WG_ANY(p_) ([&]() -> bool { __syncthreads(); if (wave == 0 && lane_id() == 0) MISC[24] = 0u; __syncthreads(); if ((p_) && lane_id() == 0) MISC[24] = 1u; __syncthreads(); return MISC[24] != 0u; }())
#define IN(k) (lo <= (k) && (k) < hi)
#define SEAM(k) do { if (IN(k) && IN((k) + 1)) xcd_barrier(BAR_NOW()); } while (0)

#define PRM(off) ((const float*)(ws + WS_PARAMS) + (off))
#define x_in (args.in[I_X])
#define ctx_in (args.in[I_CTX])
#define out (args.out)
#define mods ((float*)(ws + WS_MODS))
#define cos16 ((float*)(ws + WS_ROPE))
#define sin16 (cos16 + 4096)
#define cos8 (cos16 + 8192)
#define sin8 (cos16 + 8192 + 2048)
#define x1c ((float*)(ws + WS_X1C))
#define r_dest ((int*)(ws + WS_ROUTE))
#define r_gate ((float*)(ws + WS_ROUTE + 256 * 1024))
#define r_exp ((int*)(ws + WS_ROUTE + 512 * 1024))
#define wgcnt ((int*)(ws + WS_ROUTE + 768 * 1024))
#define W0IN8 ((unsigned char*)(ws + WS_W0IN))
#define SW_0IN ((float*)(ws + WS_SW_0IN))
#define W0OUT ((bf16*)(ws + WS_W0OUT))
#define W0GU8 ((unsigned char*)(ws + WS_W0GU))
#define SA_ROW ((float*)(ws + WS_SA_ROW))
#define SW_0GU ((float*)(ws + WS_SW_0GU))
#define W0D8 ((unsigned char*)(ws + WS_W0D))
#define W1IN8 ((unsigned char*)(ws + WS_W1IN))
#define SW_1IN ((float*)(ws + WS_SW_1IN))
#define W1OUT ((bf16*)(ws + WS_W1OUT))
#define WQ ((bf16*)(ws + WS_WQ))
#define WKV ((bf16*)(ws + WS_WKV))
#define WEGU ((bf16*)(ws + WS_WEGU))
#define WED ((bf16*)(ws + WS_WED))
#define U08 ((unsigned char*)(ws + WS_SB))
#define H18 ((unsigned char*)(ws + WS_SB))
#define Y0B ((bf16*)(ws + WS_SB))
#define Q1 ((bf16*)(ws + WS_SB))
#define Y1 ((bf16*)(ws + WS_SB))
#define PB ((bf16*)(ws + WS_H0))
#define Q0 ((bf16*)(ws + WS_Q0))
#define ACT08 ((unsigned char*)(ws + WS_ACT0))
#define H1RAW ((bf16*)(ws + WS_H1RAW))
#define K0 ((bf16*)(ws + WS_K0))
#define V0 ((bf16*)(ws + WS_V0))
#define V1T8 ((unsigned char*)(ws + 186 * MiB))
#define V0T8 ((unsigned char*)(ws + WS_SA + 32 * MiB))
#define MIX0 ((bf16*)(ws + WS_MIX0))
#define Y0 ((bf16*)(ws + WS_Y0))
#define U18 ((unsigned char*)(ws + WS_U1))
#define K1 ((bf16*)(ws + WS_K1))
#define V1 ((bf16*)(ws + WS_V1))
#define K1B ((unsigned char*)(ws + WS_K1))
#define Q1B ((unsigned char*)(ws + WS_Q1B))
#define MIX1 ((bf16*)(ws + WS_MIX1))
#define H3 ((bf16*)(ws + WS_H3))
#define XPAD8 ((unsigned char*)(ws + WS_XPAD))
#define ACT8 ((unsigned char*)(ws + WS_ACT))
#define YPAD ((bf16*)(ws + WS_YPAD))
#define W8GU ((unsigned char*)(ws + WS_W8GU))
#define W8D ((unsigned char*)(ws + WS_W8D))
#define H3B ((unsigned char*)(ws + WS_H3))
#define ACT ((bf16*)(ws + WS_ACT))

    if (IN(0)) { const int lane = lane_id(); const int tid = wave * 64 + lane; (void)tid;
        LAS float* scr = (LAS float*)(lds + wave * 16384);
        {
            constexpr int I0 = 16 * (N_IN0 / 32), I1 = 16 * 32, I2 = 16 * (2 * FF0 / 32), I3 = (FF0 / 64) * 32, I4 = 16 * (N_IN1 / 32), I5 = 16 * 32, I6 = 6 * 24, I7 = 4 * 32;
            constexpr int NST = 2 * FF0 / 32;
            constexpr int NIT = NST + N_IN0 / 32 + N_IN1 / 32 + I1 + I3 + I5 + I6 + I7;
            for (int it = gw; it < NIT; it += NGW) {
                int r = it;
                if (r < NST) { const int j0 = 32 * r, pn = j0 >> 8, half = (j0 >> 7) & 1, i = j0 & 127;
                    cvt_strip_i8(half ? args.in[I_EVWU] : args.in[I_EVWG], FF0, 128 * pn + i, DM, W0GU8, j0, SW_0GU, 1.f, scr, lane); continue; } r -= NST;
                if (r < N_IN0 / 32) { const int j0 = 32 * r, pn = j0 >> 8, tc0 = j0 & 255;
                    const int sc = (pn < 4) ? ((pn < 3 ? pn * 256 : 768) + ((tc0 & 127) >> 5) * 64 + (tc0 >> 7) * 32) : j0;
                    cvt_strip_i8(args.in[I_EVWIN], N_IN0, sc, DM, W0IN8, j0, SW_0IN, 1.f, scr, lane); continue; } r -= N_IN0 / 32;
                if (r < N_IN1 / 32) { const int j0 = 32 * r; int sc = -1; float s_ = 1.f;
                    if (j0 < C1_NQ) sc = j0; else if (j0 < C1_NK) { sc = 672 + (j0 - C1_NQ); s_ = SC64; } else if (j0 < C1_NV) sc = 1184 + (j0 - C1_NK); else if (j0 < C1_KR) sc = 1696 + (j0 - C1_NV); else if (j0 == C1_KR) sc = 640;
                    cvt_strip_i8(sc >= 0 ? args.in[I_ODWIN] : nullptr, 2208, sc >= 0 ? sc : 0, DM, W1IN8, j0, SW_1IN, s_, scr, lane); continue; } r -= N_IN1 / 32;
                if (r < I1) { const int kb = r / 32, nb = r % 32; cvt_item(args.in[I_EVWOUT], DM, 32 * nb, 64 * kb, W0OUT, DM, 32 * nb, 1.f, scr, lane); continue; } r -= I1;
                if (r < I3) { const int kb = r / 32, nb = r % 32; cvt_item8(args.in[I_EVWD], DM, 32 * nb, 64 * kb, W0D8, FF0, 32 * nb, 128.f, scr, lane); continue; } r -= I3;
                if (r < I5) { const int kb = r / 32, nb = r % 32; cvt_item(args.in[I_ODWOUT], DM, 32 * nb, 64 * kb, W1OUT, DM, 32 * nb, 1.f, scr, lane); continue; } r -= I5;
                if (r < I6) { const int kb = r / 24, nb = r % 24; cvt_item(args.in[I_ODWQUP], 768, 32 * nb, 64 * kb, WQ, 384, 32 * nb, SC96, scr, lane); continue; } r -= I6;
                { const int kb = r / 32, nb = r % 32; const int j0 = 32 * nb; const int sc = (j0 < 512) ? ((j0 >> 6) * 128 + (j0 & 63)) : (((j0 - 512) >> 6) * 128 + 64 + (j0 & 63));
                    cvt_item(args.in[I_ODWKVUP], 1024, sc, 64 * kb, WKV, 256, j0, 1.f, scr, lane); }
            }
        }
        __syncthreads();
        {
            LAS float* sv = (LAS float*)(lds + 0);
            LAS float* part = (LAS float*)(lds + 16384);
            for (int i = tid; i < 3 * 1024; i += 512) { const int v = i >> 10, k = i & 1023; const float c = (v < 2) ? args.in[I_C][v * 1024 + k] : args.in[I_CCTX][k]; sv[i] = c / (1.0f + __expf(-c)); }
            __syncthreads();
            for (int un = bx; un < 2 * 96; un += G) {
                const int l = un / 96, cb = un % 96; const int col = cb * 64 + (tid & 63), kq = tid >> 6;
                const float* W = args.in[I_WADA] + (size_t)l * 1024 * 6144 + col;
                float a0 = 0.f, a1 = 0.f, a2 = 0.f;
#pragma unroll 32
                for (int k = kq * 128; k < kq * 128 + 128; ++k) { const float w = W[(size_t)k * 6144]; a0 += sv[k] * w; a1 += sv[1024 + k] * w; a2 += sv[2048 + k] * w; }
                part[(kq * 3 + 0) * 64 + (tid & 63)] = a0; part[(kq * 3 + 1) * 64 + (tid & 63)] = a1; part[(kq * 3 + 2) * 64 + (tid & 63)] = a2;
                __syncthreads();
                if (tid < 192) { const int v = tid >> 6, c = tid & 63; float s = 0.f;
#pragma unroll
                    for (int q = 0; q < 8; ++q) s += part[(q * 3 + v) * 64 + c];
                    mods[((size_t)l * 3 + v) * 6144 + cb * 64 + c] = s + args.in[I_BADA][l * 6144 + cb * 64 + c]; }
                __syncthreads();
            }
        }
        {
#define CP_(I_, off_, n_) for (int i = bx * 512 + tid; i < (n_); i += G * 512) ((float*)(ws + WS_PARAMS))[(off_) + i] = args.in[I_][i];
            CP_(I_LN1G, P_LN1G, 2048) CP_(I_LN1B, P_LN1B, 2048) CP_(I_LN2G, P_LN2G, 2048) CP_(I_LN2B, P_LN2B, 2048) CP_(I_EVQG, P_QG, 64) CP_(I_EVKG, P_KG, 64) CP_(I_EVWPOOL, P_WPOOL, 16384)
            CP_(I_EVPSCALE, P_PSC, 256) CP_(I_ODQLG, P_QLG, 384) CP_(I_ODKVLG, P_KVLG, 256) CP_(I_ODNABIAS, P_NAB, 3720) CP_(I_ODWR, P_WR, 8192) CP_(I_ODBR, P_BR, 8)
#undef CP_
        }
        {
            const int gt = bx * 512 + tid;
            if (gt < 4096) { const int pos = gt >> 4, i = gt & 15; const float inv = powf(10000.0f, -(float)i / 16.0f); const float a = (float)pos * inv; cos16[gt] = cosf(a); sin16[gt] = sinf(a); }
            else if (gt < 4096 + 2048) { const int g2 = gt - 4096, pos = g2 >> 3, i = g2 & 7; const float inv = powf(10000.0f, -(float)i / 8.0f); const float a = (float)pos * inv; cos8[g2] = cosf(a); sin8[g2] = sinf(a); }
        }
    }
    SEAM(0);

    if (IN(1)) { const int lane = lane_id(); const int tid = wave * 64 + lane; (void)tid;
#define P1_SRC(m_) (((m_) < MS) ? x_in + (size_t)(m_) * DM : ctx_in + (size_t)((m_) - MS) * DM)
#define P1_ALD(Q, m_) do { const int ml = ((m_) < hi) ? (m_) : m0; ald_row16(Q, P1_SRC(ml), lane); } while (0)
#define P1_ROW(Q, m_) do { const int mm = (m_); Row16 u; \
            _Pragma("unroll") for (int j = 0; j < 4; ++j) u.v[j] = Q.v[j] * (1.0f + SC.v[j]) + SH.v[j]; \
            st_row_i8(U08 + (size_t)mm * DM, SA_ROW + mm, lane, u); } while (0)
        for (int seg = 0; seg < 3; ++seg) {
            const int lo = seg * SEQ, hi = (seg < 2) ? lo + SEQ : MA;
            int m = lo + ((gw - lo % NGW + NGW) % NGW);
            if (m >= hi) continue;
            const int m0 = m; Row16 qa, qb, qc, qd;
            P1_ALD(qa, m); P1_ALD(qb, m + NGW); P1_ALD(qc, m + 2 * NGW); P1_ALD(qd, m + 3 * NGW);
            const float* md = mods + (size_t)(0 * 3 + seg) * 6144;
            const Row16 SH = ld_row_f32(md, lane), SC = ld_row_f32(md + 1024, lane);
            ROW16_WAIT(12, qa); P1_ROW(qa, m); P1_ALD(qa, m + 4 * NGW);
            if (m + NGW < hi) { ROW16_WAIT(17, qb); P1_ROW(qb, m + NGW); P1_ALD(qb, m + 5 * NGW); }
            if (m + 2 * NGW < hi) { ROW16_WAIT(22, qc); P1_ROW(qc, m + 2 * NGW); P1_ALD(qc, m + 6 * NGW); }
            if (m + 3 * NGW < hi) { ROW16_WAIT(27, qd); P1_ROW(qd, m + 3 * NGW); P1_ALD(qd, m + 7 * NGW); }
            for (m += 4 * NGW; m < hi; m += 4 * NGW) {
                ROW16_WAIT(27, qa); P1_ROW(qa, m); P1_ALD(qa, m + 4 * NGW);
                if (m + NGW < hi) { ROW16_WAIT(27, qb); P1_ROW(qb, m + NGW); P1_ALD(qb, m + 5 * NGW); }
                if (m + 2 * NGW < hi) { ROW16_WAIT(27, qc); P1_ROW(qc, m + 2 * NGW); P1_ALD(qc, m + 6 * NGW); }
                if (m + 3 * NGW < hi) { ROW16_WAIT(27, qd); P1_ROW(qd, m + 3 * NGW); P1_ALD(qd, m + 7 * NGW); }
            }
            ROW16_WAIT(0, qa); ROW16_WAIT(0, qb); ROW16_WAIT(0, qc); ROW16_WAIT(0, qd);
        }
#undef P1_ROW
#undef P1_ALD
#undef P1_SRC
    }
    SEAM(1);

    if (IN(2)) { const int lane = lane_id(); const int tid = wave * 64 + lane; (void)tid;
        pg8::Gemm g{U08, W0IN8, DM, DM, 0, SA_ROW, SW_0IN, 0}; pg8::StaticOrder S; S.init(MA / 256, N_IN0 / 256, G, bx);
        pg8::EpiQKV E{ws, WS_Q0, WS_K0, WS_V0, WS_H0, WS_ROPE, PRM(P_QG), PRM(P_KG)};
        for (int rep = 0; rep < REP_G; ++rep) pg8::gemm_phase<pg8::EpiQKV, pg8::StaticOrder, 2>(lds, g, S, E, wave);
    }
    SEAM(2);

    if (IN(3)) { const int lane = lane_id(); build_vt_images(V0, 256, 4, V0T8, gw, NGW, (LAS unsigned char*)lds + wave * 4096, lane); }
    SEAM(3);

    if (IN(4)) { const int lane = lane_id(); const int tid = wave * 64 + lane; (void)tid;
        {
            LAS float* wp = (LAS float*)lds;
            for (int i = tid; i < 4 * 64 * 64; i += 512) wp[i] = PRM(P_WPOOL)[i];
            __syncthreads();
            const float* psc = PRM(P_PSC);
#define POOL_G(g) { bf16x8 wfr[2][4];        \
                _Pragma("unroll") for (int s_ = 0; s_ < 2; ++s_) _Pragma("unroll") for (int nb = 0; nb < 4; ++nb) { \
                    const LAS float* wq = wp + ((g) * 64 + 32 * s_ + 8 * (lane >> 4)) * 64 + 16 * nb + (lane & 15); \
                    u32x4 t_; t_.x = pk2(wq[0], wq[64]); t_.y = pk2(wq[128], wq[192]); t_.z = pk2(wq[256], wq[320]); t_.w = pk2(wq[384], wq[448]); \
                    wfr[s_][nb] = __builtin_bit_cast(bf16x8, t_); } \
                float ps4[4]; _Pragma("unroll") for (int nb = 0; nb < 4; ++nb) ps4[nb] = psc[(g) * 64 + 16 * nb + (lane & 15)]; \
                LAS bf16* yb = (LAS bf16*)(lds + 65536 + wave * 2304);          \
                for (int rep = 0; rep < REP_POOL; ++rep) for (int blk = gw; blk < MA / 16; blk += NGW) { \
                const int m0 = blk * 16; const bool isseq = m0 < MS; const int L = isseq ? SEQ : CTX; const int pos0 = isseq ? (m0 & (SEQ - 1)) : ((m0 - MS) & 255); \
                    { constexpr int LO = 1 << (g), NV = 16 + 2 * LO; float pf[NV + 1]; pf[0] = 0.f; float own[16]; \
                    _Pragma("unroll") for (int i = 0; i < NV; ++i) { const int q = pos0 - LO + i; const bool ok = (q >= 0) && (q < L); \
                        const float v = ok ? bf2f(PB[(size_t)(m0 - LO + i) * 256 + (g) * 64 + lane]) : 0.f; if (i >= LO && i < LO + 16) own[i - LO] = v; pf[i + 1] = v; } \
                    _Pragma("unroll") for (int i = 0; i < NV; ++i) pf[i + 1] += pf[i]; \
                    LDS_WAIT(); \
                    _Pragma("unroll") for (int k = 0; k < 16; ++k) { const int p = pos0 + k; const int st = max(p - LO, 0), en = min(p + LO, L); yb[k * 72 + lane] = (bf16)f2bf((pf[k + 2 * LO] - pf[k]) / (float)(en - st) - own[k]); } \
                    LDS_WAIT(); asm volatile("" ::: "memory"); \
                    const bf16x8 a0 = *(const LAS bf16x8*)(yb + (lane & 15) * 72 + 8 * (lane >> 4)), a1 = *(const LAS bf16x8*)(yb + (lane & 15) * 72 + 32 + 8 * (lane >> 4)); \
                    _Pragma("unroll") for (int nb = 0; nb < 4; ++nb) { f32x4 d = {0.f, 0.f, 0.f, 0.f};         \
                        d = __builtin_amdgcn_mfma_f32_16x16x32_bf16(a0, wfr[0][nb], d, 0, 0, 0); d = __builtin_amdgcn_mfma_f32_16x16x32_bf16(a1, wfr[1][nb], d, 0, 0, 0); \
                        _Pragma("unroll") for (int r = 0; r < 4; ++r) MIX0[(size_t)(m0 + 4 * (lane >> 4) + r) * DM + 768 + (g) * 64 + 16 * nb + (lane & 15)] = (bf16)f2bf(d[r] * ps4[nb]); } } } }
            POOL_G(0) POOL_G(1) POOL_G(2) POOL_G(3)
#undef POOL_G
            __syncthreads();
        }
        {
            float refB;
            { float mq = fabsf(PRM(P_QG)[lane]), mk = fabsf(PRM(P_KG)[lane]);
#pragma unroll
              for (int o = 1; o < 64; o <<= 1) { mq = fmaxf(mq, shx(mq, o)); mk = fmaxf(mk, shx(mk, o)); }
              refB = __uint_as_float((unsigned)__builtin_amdgcn_readfirstlane((int)__float_as_uint(SC64 * 64.0f * mq * mk * 1.14f))); }
            const bool fixref = refB < 40.0f;
#define GQA_UNIT(FIX_, m0_, h_, b_, kvh_, NT_) att64q8::attn_unit<8, 768, 256, 256, DM, FIX_>((const unsigned char*)Q0 + (size_t)(m0_) * 768 + (h_) * 64, (const unsigned char*)K0 + (size_t)(b_) * NKEY * 256 + (kvh_) * 64, V0T8 + (size_t)((b_) * 4 + (kvh_)) * (NKEY / 64) * 4096, \
                                                  MIX0 + (size_t)(m0_) * DM + (h_) * 64, (NT_), (char*)lds_raw, wave, refB)
            for (int rep = 0; rep < REP_A0; ++rep)
            for (int i = 0; i < 6; ++i) {
                const int grp = vcu >> 5, b = grp >> 2, kvh = grp & 3; const int local = i * 32 + (vcu & 31); const int gq = local >> 6, qb = local & 63; const int h = kvh * 3 + gq;
                bool redo = !fixref;
                if (fixref) { const bool sunk = GQA_UNIT(1, b * SEQ + qb * 256, h, b, kvh, NKEY / 64); redo = WG_ANY(sunk); }
                if (redo) (void)GQA_UNIT(0, b * SEQ + qb * 256, h, b, kvh, NKEY / 64);
            }
            if (vcu < 24) { const int b = vcu / 12, h = vcu % 12, kvh = h / 3;
                bool redo = !fixref;
                if (fixref) { const bool sunk = GQA_UNIT(1, MS + b * CTX, h, b, kvh, CTX / 64); redo = WG_ANY(sunk); }
                if (redo) (void)GQA_UNIT(0, MS + b * CTX, h, b, kvh, CTX / 64); }
#undef GQA_UNIT
        }
    }
    SEAM(4);

    if (IN(5)) { const int lane = lane_id(); const int tid = wave * 64 + lane; (void)tid;
        pg8::Gemm g{MIX0, W0OUT, DM, DM, 0, 0, 0}; pg8::StaticOrder S; S.init(MA / 256, DM / 256, G, bx);
        pg8::EpiPlain E{Y0, DM};
        for (int rep = 0; rep < REP_G; ++rep) pg8::gemm_phase(lds, g, S, E, wave);
    }
    SEAM(5);

    if (IN(6)) { const int lane = lane_id(); const int tid = wave * 64 + lane; (void)tid;
        const Row16 LG = ld_row_f32(PRM(P_LN1G), lane), LB = ld_row_f32(PRM(P_LN1B), lane);
#define P6_ALD(Q, m_) do { const int ml = ((m_) < hi) ? (m_) : m0; ald_rowin(Q, (ml < MS) ? x_in + (size_t)ml * DM : ctx_in + (size_t)(ml - MS) * DM, Y0 + (size_t)ml * DM, lane); } while (0)
#define P6_ROW(Q, m_) do { const int mm = (m_); Row16 z; \
            _Pragma("unroll") for (int j = 0; j < 4; ++j) z.v[j] = Q.x[j] * ALPHA + GT.v[j] * bf4(Q.y[j]); \
            ln_row2(z, LG, LB); \
            st_row_f32((mm < MS) ? out + (size_t)mm * DM : x1c + (size_t)(mm - MS) * DM, lane, z); \
            _Pragma("unroll") for (int j = 0; j < 4; ++j) z.v[j] = z.v[j] * (1.0f + SC.v[j]) + SH.v[j]; \
            st_row_i8(H18 + (size_t)mm * DM, SA_ROW + mm, lane, z); } while (0)
        for (int seg = 0; seg < 3; ++seg) {
            const int lo = seg * SEQ, hi = (seg < 2) ? lo + SEQ : MA;
            int m = lo + ((gw - lo % NGW + NGW) % NGW);
            if (m >= hi) continue;
            const int m0 = m; RowIn qa, qb, qc;
            P6_ALD(qa, m); P6_ALD(qb, m + NGW); P6_ALD(qc, m + 2 * NGW);
            const float* md = mods + (size_t)(0 * 3 + seg) * 6144;
            const Row16 GT = ld_row_f32(md + 2 * 1024, lane), SH = ld_row_f32(md + 3 * 1024, lane), SC = ld_row_f32(md + 4 * 1024, lane);
            ROW_WAIT(16, qa); P6_ROW(qa, m); P6_ALD(qa, m + 3 * NGW);
            if (m + NGW < hi) { ROW_WAIT(25, qb); P6_ROW(qb, m + NGW); P6_ALD(qb, m + 4 * NGW); }
            if (m + 2 * NGW < hi) { ROW_WAIT(34, qc); P6_ROW(qc, m + 2 * NGW); P6_ALD(qc, m + 5 * NGW); }
            for (m += 3 * NGW; m < hi; m += 3 * NGW) {
                ROW_WAIT(34, qa); P6_ROW(qa, m); P6_ALD(qa, m + 3 * NGW);
                if (m + NGW < hi) { ROW_WAIT(34, qb); P6_ROW(qb, m + NGW); P6_ALD(qb, m + 4 * NGW); }
                if (m + 2 * NGW < hi) { ROW_WAIT(34, qc); P6_ROW(qc, m + 2 * NGW); P6_ALD(qc, m + 5 * NGW); }
            }
            ROW_WAIT(0, qa); ROW_WAIT(0, qb); ROW_WAIT(0, qc);
        }
#undef P6_ROW
#undef P6_ALD
#undef P6_LD
    }
    SEAM(6);

    if (IN(7)) { const int lane = lane_id(); const int tid = wave * 64 + lane; (void)tid;
        pg8::Gemm g{H18, W0GU8, DM, DM, 0, SA_ROW, SW_0GU, 0}; pg8::StaticOrder S; S.init(MA / 256, 2 * FF0 / 256, G, bx);
        pg8::EpiSwiglu8 E{ACT08, FF0, 1.0f};
        for (int rep = 0; rep < REP_G; ++rep) pg8::gemm_phase<pg8::EpiSwiglu8, pg8::StaticOrder, 2>(lds, g, S, E, wave);
    }
    SEAM(7);

    if (IN(8)) { const int lane = lane_id(); const int tid = wave * 64 + lane; (void)tid;
        pg8::Gemm g{ACT08, W0D8, FF0, FF0, 0, 0, 0}; pg8::StaticOrder S; S.init(MA / 256, DM / 256, G, bx);
        pg8::EpiPlainS E{Y0B, DM, 1.0f / 1024.0f};
        for (int rep = 0; rep < REP_G; ++rep) pg8::gemm_phase<pg8::EpiPlainS, pg8::StaticOrder, true>(lds, g, S, E, wave);
    }
    SEAM(8);

    if (IN(9)) { const int lane = lane_id(); const int tid = wave * 64 + lane; (void)tid;
        const Row16 LG = ld_row_f32(PRM(P_LN2G), lane), LB = ld_row_f32(PRM(P_LN2B), lane);
#define P9_ALD(Q, m_) do { const int ml = ((m_) < hi) ? (m_) : m0; ald_rowin(Q, (ml < MS) ? out + (size_t)ml * DM : x1c + (size_t)(ml - MS) * DM, Y0B + (size_t)ml * DM, lane); } while (0)
#define P9_ROW(Q, m_) do { const int mm = (m_); Row16 z; \
            _Pragma("unroll") for (int j = 0; j < 4; ++j) z.v[j] = Q.x[j] * ALPHA + GT.v[j] * bf4(Q.y[j]); \
            ln_row2(z, LG, LB); \
            if (seg < 2) st_row_f32(out + (size_t)mm * DM, lane, z); \
            _Pragma("unroll") for (int j = 0; j < 4; ++j) z.v[j] = z.v[j] * (1.0f + SC.v[j]) + SH.v[j]; \
            st_row_i8(U18 + (size_t)mm * DM, SA_ROW + mm, lane, z); } while (0)
        for (int seg = 0; seg < 3; ++seg) {
            const int lo = seg * SEQ, hi = (seg < 2) ? lo + SEQ : MA;
            int m = lo + ((gw - lo % NGW + NGW) % NGW);
            if (m >= hi) continue;
            const int m0 = m; RowIn qa, qb, qc;
            P9_ALD(qa, m); P9_ALD(qb, m + NGW); P9_ALD(qc, m + 2 * NGW);
            const float* md0 = mods + (size_t)(0 * 3 + seg) * 6144; const float* md1 = mods + (size_t)(1 * 3 + seg) * 6144;
            const Row16 GT = ld_row_f32(md0 + 5 * 1024, lane), SH = ld_row_f32(md1, lane), SC = ld_row_f32(md1 + 1024, lane);
            ROW_WAIT(16, qa); P9_ROW(qa, m); P9_ALD(qa, m + 3 * NGW);
            if (m + NGW < hi) { ROW_WAIT(25, qb); P9_ROW(qb, m + NGW); P9_ALD(qb, m + 4 * NGW); }
            if (m + 2 * NGW < hi) { ROW_WAIT(34, qc); P9_ROW(qc, m + 2 * NGW); P9_ALD(qc, m + 5 * NGW); }
            for (m += 3 * NGW; m < hi; m += 3 * NGW) {
                ROW_WAIT(34, qa); P9_ROW(qa, m); P9_ALD(qa, m + 3 * NGW);
                if (m + NGW < hi) { ROW_WAIT(34, qb); P9_ROW(qb, m + NGW); P9_ALD(qb, m + 4 * NGW); }
                if (m + 2 * NGW < hi) { ROW_WAIT(34, qc); P9_ROW(qc, m + 2 * NGW); P9_ALD(qc, m + 5 * NGW); }
            }
            ROW_WAIT(0, qa); ROW_WAIT(0, qb); ROW_WAIT(0, qc);
        }
#undef P9_ROW
#undef P9_ALD
#undef P9_LD
    }
    SEAM(9);

    if (IN(10)) { const int lane = lane_id(); const int tid = wave * 64 + lane; (void)tid;
        pg8::Gemm g{U18, W1IN8, DM, DM, 0, SA_ROW, SW_1IN, 0}; pg8::StaticOrder S; S.init(MA / 256, N_IN1 / 256, G, bx);
        pg8::EpiPlain E{H1RAW, N_IN1};
        for (int rep = 0; rep < REP_G; ++rep) pg8::gemm_phase<pg8::EpiPlain, pg8::StaticOrder, 2>(lds, g, S, E, wave);
    }
    SEAM(10);

    if (IN(11)) { const int lane = lane_id(); const int tid = wave * 64 + lane; (void)tid;
        const float* gq = PRM(P_QLG); const float* gk = PRM(P_KVLG);
        for (int m = gw; m < MA; m += NGW) {
            bf16* hrow = H1RAW + (size_t)m * N_IN1;
            {
                unsigned w[3]; float a[6]; float ssq = 0.f;
#pragma unroll
                for (int j = 0; j < 3; ++j) { w[j] = *(const unsigned*)(hrow + C1_CQ + j * 128 + lane * 2); a[2 * j] = __uint_as_float(w[j] << 16); a[2 * j + 1] = __uint_as_float(w[j] & 0xffff0000u); ssq += a[2 * j] * a[2 * j] + a[2 * j + 1] * a[2 * j + 1]; }
                const float rstd = 1.0f / sqrtf(wave_sum(ssq) * (1.f / 384.f) + EPS);
#pragma unroll
                for (int j = 0; j < 3; ++j) { const int k = j * 128 + lane * 2; *(unsigned*)(hrow + C1_CQ + k) = pk2(a[2 * j] * rstd * gq[k], a[2 * j + 1] * rstd * gq[k + 1]); }
            }
            {
                unsigned w[2]; float a[4]; float ssq = 0.f;
#pragma unroll
                for (int j = 0; j < 2; ++j) { w[j] = *(const unsigned*)(hrow + C1_CKV + j * 128 + lane * 2); a[2 * j] = __uint_as_float(w[j] << 16); a[2 * j + 1] = __uint_as_float(w[j] & 0xffff0000u); ssq += a[2 * j] * a[2 * j] + a[2 * j + 1] * a[2 * j + 1]; }
                const float rstd = 1.0f / sqrtf(wave_sum(ssq) * (1.f / 256.f) + EPS);
#pragma unroll
                for (int j = 0; j < 2; ++j) { const int k = j * 128 + lane * 2; *(unsigned*)(hrow + C1_CKV + k) = pk2(a[2 * j] * rstd * gk[k], a[2 * j + 1] * rstd * gk[k + 1]); }
            }
            {
                const bool isseq = m < MS; const int t = m & (SEQ - 1); const int pr = t >> 6, pc = t & 63; const int i = lane & 31;
                float v = bf2f(hrow[C1_KR + i]);
                const int pos = (i & 16) ? pc : pr; const int fi = i & 7; const bool first = (i & 8) == 0;
                const float cs = isseq ? cos8[pos * 8 + fi] : 1.f, sn = isseq ? sin8[pos * 8 + fi] : 0.f;
                const float pv = shx(v, 8);
                const float o = first ? v * cs - pv * sn : pv * sn + v * cs;
                const unsigned char ob = (unsigned char)(__builtin_amdgcn_cvt_pk_fp8_f32(o, 0.f, 0, false) & 0xff); const int kr = kvrow(m);
                if (lane < 32) {
#pragma unroll
                    for (int h = 0; h < 8; ++h) { K1B[(size_t)kr * 1024 + h * 128 + 64 + i] = ob; K1B[(size_t)kr * 1024 + h * 128 + 96 + i] = 0; } }
            }
        }
    }
    SEAM(11);

    if (IN(12)) { const int lane = lane_id(); const int tid = wave * 64 + lane; (void)tid;
        { pg8::Gemm g{H1RAW + C1_CQ, WQ, 384, N_IN1, 0, 0, 0}; pg8::StaticOrder S; S.init(MS / 256, 768 / 256, G, bx);
          pg8::EpiPlain E{Q1, 768};
          for (int rep = 0; rep < REP_G; ++rep) pg8::gemm_phase(lds, g, S, E, wave); }
        { pg8::Gemm g{H1RAW + C1_CKV, WKV, 256, N_IN1, 0, 0, 0}; pg8::StaticOrder S; S.init(MA / 256, 1024 / 256, G, bx);
          pg8::EpiKV E{K1B, V1};
          for (int rep = 0; rep < REP_G; ++rep) pg8::gemm_phase(lds, g, S, E, wave); }
    }
    SEAM(12);

    if (IN(13)) { const int lane = lane_id(); const int tid = wave * 64 + lane; (void)tid;
        build_vt_images(V1, 512, 8, V1T8, gw, NGW, (LAS unsigned char*)lds + 4096 + wave * 4096, lane);
        __syncthreads();
        {
            float mx0 = 0.f, mx1 = 0.f;
            for (int r = gw; r < 2 * NKEY; r += NGW) {
                const u32x4 kb = *(const u32x4*)(K1B + (size_t)r * 1024 + lane * 16); float q2 = 0.f;
#pragma unroll
                for (int c = 0; c < 4; ++c) { const int w_ = (int)kb[c]; const float a0 = __builtin_amdgcn_cvt_f32_fp8(w_, 0), a1 = __builtin_amdgcn_cvt_f32_fp8(w_, 1), a2 = __builtin_amdgcn_cvt_f32_fp8(w_, 2), a3 = __builtin_amdgcn_cvt_f32_fp8(w_, 3);
                    q2 += (a0 * a0 + a1 * a1) + (a2 * a2 + a3 * a3); }
                q2 += shx(q2, 1); q2 += shx(q2, 2); q2 += shx(q2, 4);
                if (r < NKEY) mx0 = fmaxf(mx0, q2); else mx1 = fmaxf(mx1, q2);
            }
            LAS float* km = (LAS float*)lds;
            if ((lane & 7) == 0) { km[wave * 16 + (lane >> 3)] = mx0; km[wave * 16 + 8 + (lane >> 3)] = mx1; }
            __syncthreads();
            if (tid < 16) { float m_ = 0.f;
#pragma unroll
                for (int w = 0; w < 8; ++w) m_ = fmaxf(m_, km[w * 16 + tid]);
                __hip_atomic_fetch_max((unsigned*)(ctl + CW_KMAX) + tid, __float_as_uint(m_), __ATOMIC_RELAXED, __HIP_MEMORY_SCOPE_AGENT); }
            __syncthreads();
        }
        for (int m = gw; m < MS; m += NGW) {
            const int t = m & (SEQ - 1); const int pr = t >> 6, pc = t & 63;
            const int h = lane >> 3, w = lane & 7; const bf16* qh = Q1 + (size_t)m * 768 + h * 96; unsigned char* dq = Q1B + (size_t)m * 1024 + h * 128;
            const u32x4 nraw = *(const u32x4*)(qh + 8 * w); const u32x2 raw = *(const u32x2*)(qh + 64 + 4 * w);
            {   const f32x4 n0 = bf4((u32x2){nraw.x, nraw.y}) * 8.0f, n1 = bf4((u32x2){nraw.z, nraw.w}) * 8.0f;
                int w0 = 0, w1 = 0; w0 = __builtin_amdgcn_cvt_pk_fp8_f32(n0[0], n0[1], w0, false); w0 = __builtin_amdgcn_cvt_pk_fp8_f32(n0[2], n0[3], w0, true);
                w1 = __builtin_amdgcn_cvt_pk_fp8_f32(n1[0], n1[1], w1, false); w1 = __builtin_amdgcn_cvt_pk_fp8_f32(n1[2], n1[3], w1, true);
                u32x2 wv; wv.x = (unsigned)w0; wv.y = (unsigned)w1; *(u32x2*)(dq + 8 * w) = wv; }
            float v[4] = {__uint_as_float(raw.x << 16), __uint_as_float(raw.x & 0xffff0000u), __uint_as_float(raw.y << 16), __uint_as_float(raw.y & 0xffff0000u)};
            const int pos = (w & 4) ? pc : pr; const bool first = (w & 2) == 0; float o[4];
#pragma unroll
            for (int j = 0; j < 4; ++j) { const int fi = 4 * (w & 1) + j; const float cs = cos8[pos * 8 + fi], sn = sin8[pos * 8 + fi]; const float pv = shx(v[j], 2);
                o[j] = (first ? v[j] * cs - pv * sn : pv * sn + v[j] * cs) * 8.0f; }
            int wr_ = 0; wr_ = __builtin_amdgcn_cvt_pk_fp8_f32(o[0], o[1], wr_, false); wr_ = __builtin_amdgcn_cvt_pk_fp8_f32(o[2], o[3], wr_, true);
            *(int*)(dq + 64 + 4 * w) = wr_; *(int*)(dq + 96 + 4 * w) = 0;
        }
    }
    SEAM(13);

    if (IN(14)) { const int lane = lane_id(); const int tid = wave * 64 + lane; (void)tid;
        const int grp = vcu >> 4, b = grp >> 3, h = grp & 7;
        {   const att::NoMask nm;
            for (int rep = 0; rep < REP_A1; ++rep)
            for (int i = 0; i < 4; ++i) {
                int b_ = b, h_ = h; asm volatile("" : "+s"(b_), "+s"(h_));
                const float kmax_ = sqrtf(__uint_as_float(__hip_atomic_load((unsigned*)(ctl + CW_KMAX) + b_ * 8 + h_, RLX_AGENT)));
                const int qb = i * 16 + (vcu & 15); const int m0 = b_ * SEQ + qb * 256;
#pragma unroll 1
                for (int pass = 0; pass < 2; ++pass) {
                    const bool sunk = att96q8::attn_unit<8, 1024, 1024, 512, DM>(Q1B + (size_t)m0 * 1024 + h_ * 128, K1B + (size_t)b_ * NKEY * 1024 + h_ * 128, V1T8 + (size_t)(b_ * 8 + h_) * (NKEY / 64) * 4096,
                                                        MIX1 + (size_t)m0 * DM + h_ * 64, NKEY / 64, (char*)lds_raw, wave, kmax_, pass == 0);
                    if (!WG_ANY(sunk)) break; }
            }
        }
        {
            const int lane = lane_id(); const int tid = wave * 64 + lane;
            LAS float* bl = (LAS float*)(lds + att::L_BIAS);
            if (tid < 465) bl[tid] = PRM(P_NAB)[h * 465 + tid] * LOG2E;
            __syncthreads();
            for (int rep = 0; rep < REP_NA; ++rep)
            for (int i = 0; i < 4; ++i) {
                const int rb = i * 16 + (vcu & 15); const int r0 = rb * 4, r = r0 + (wave >> 1);
                att::NaMask mk; mk.ctx_row0 = MS + b * CTX; mk.seq_row0 = (long)b * SEQ; mk.kr0 = min(max(r0 - 4, 0), 248);
                mk.r = r; mk.rs = min(max(r - 4, 0), 248); mk.j = (wave & 1) * 32 + (lane & 31); mk.cs = min(max(mk.j - 8, 0), 48); mk.bias = bl;
                const int klast = min(max(r0 + 3 - 4, 0), 248) + 7; const int NT = 4 + (klast - mk.kr0 + 1);
                const int m0 = b * SEQ + rb * 256 + wave * 32;
                att::attn_unit<64>(H1RAW + (size_t)m0 * N_IN1 + C1_NQ + h * 64, N_IN1, H1RAW + C1_NK + h * 64, N_IN1, H1RAW + C1_NV + h * 64, N_IN1,
                                   MIX1 + (size_t)m0 * DM + 512 + h * 64, DM, NT, mk, lds, wave);
            }
        }
    }
    SEAM(14);

    if (IN(15)) { const int lane = lane_id(); const int tid = wave * 64 + lane; (void)tid;
#define MOE_CVT() do { \
        LAS float* scr = (LAS float*)(lds + wave * 16384); \
        {   constexpr int IG = 16 * (2 * FFE / 32), ID = (FFE / 64) * 32, IE = IG + ID; \
            for (int it = gw; it < NEXP * IE; it += NGW) { \
                const int e = it / IE; int r = it % IE; \
                if (r < IG) { const int nbk = 2 * FFE / 32, kb = r / nbk, nb = r % nbk; const int j0 = 32 * nb, pn = j0 >> 8, half = (j0 >> 7) & 1, i = j0 & 127; \
                    cvt_item8((half ? args.in[I_ODWU] : args.in[I_ODWG]) + (size_t)e * DM * FFE, FFE, 128 * pn + i, 64 * kb, W8GU + (size_t)e * 2 * FFE * DM, DM, j0, 32.f, scr, lane); } \
                else { r -= IG; const int kb = r / 32, nb = r % 32; cvt_item8(args.in[I_ODWD] + (size_t)e * FFE * DM, DM, 32 * nb, 64 * kb, W8D + (size_t)e * DM * FFE, FFE, 32 * nb, 128.f, scr, lane); } \
            } \
        } \
     \
        } while (0)
        if (vcu & 1) { MOE_CVT(); __syncthreads(); }
        { pg8::Gemm g{MIX1, W1OUT, DM, DM, 0, 0, 0}; pg8::StaticOrder S; S.init(MS / 256, DM / 256, G, bx);
          pg8::EpiPlain E{Y1, DM};
          for (int rep = 0; rep < REP_G; ++rep) pg8::gemm_phase(lds, g, S, E, wave); }
        if (!(vcu & 1)) MOE_CVT();
#undef MOE_CVT
    }
    SEAM(15);

    if (IN(16)) { const int lane = lane_id(); const int tid = wave * 64 + lane; (void)tid;
        const float* br_ = PRM(P_BR);
        LAS float* wl = (LAS float*)(lds + 1024);
        for (int i = tid; i < 8192; i += 512) wl[(i & 7) * 1024 + (i >> 3)] = PRM(P_WR)[i];
        __syncthreads();
        const Row16 LG = ld_row_f32(PRM(P_LN1G) + DM, lane), LB = ld_row_f32(PRM(P_LN1B) + DM, lane);
        int cnt[8];
#pragma unroll
        for (int e = 0; e < 8; ++e) cnt[e] = 0;
        const int mbeg = gw * 16; const int v = mbeg >> 14; const float* md = mods + (size_t)(1 * 3 + v) * 6144;
        const Row16 GT = ld_row_f32(md + 2 * 1024, lane), SH = ld_row_f32(md + 3 * 1024, lane), SC = ld_row_f32(md + 4 * 1024, lane);
#define P16_LD(m_) ld_rowin(out + (size_t)(m_) * DM, Y1 + (size_t)(m_) * DM, lane)
        RowIn q0 = P16_LD(mbeg), q1 = P16_LD(mbeg + 1), q2 = P16_LD(mbeg + 2);
        for (int m = mbeg; m < mbeg + 16; ++m) {
            const RowIn cur = q0; q0 = q1; q1 = q2;
            if (m + 3 < mbeg + 16) q2 = P16_LD(m + 3);
            Row16 z;
#pragma unroll
            for (int j = 0; j < 4; ++j) z.v[j] = cur.x[j] * ALPHA + GT.v[j] * bf4(cur.y[j]);
            ln_row2(z, LG, LB);
            st_row_f32(out + (size_t)m * DM, lane, z);
#pragma unroll
            for (int j = 0; j < 4; ++j) z.v[j] = z.v[j] * (1.0f + SC.v[j]) + SH.v[j];
            { unsigned* hp = (unsigned*)(H3B + (size_t)m * 1024) + lane;
#pragma unroll
              for (int j = 0; j < 4; ++j) { int w_ = 0; w_ = __builtin_amdgcn_cvt_pk_fp8_f32(z.v[j][0] * 4.0f, z.v[j][1] * 4.0f, w_, false); w_ = __builtin_amdgcn_cvt_pk_fp8_f32(z.v[j][2] * 4.0f, z.v[j][3] * 4.0f, w_, true); hp[64 * j] = (unsigned)w_; } }
            float lg[8];
#pragma unroll
            for (int e = 0; e < 8; ++e) { float a = 0.f;
#pragma unroll
                for (int j = 0; j < 4; ++j) { const f32x4 w = *(const LAS f32x4*)(wl + e * 1024 + 256 * j + 4 * lane); a += (z.v[j][0] * w[0] + z.v[j][1] * w[1]) + (z.v[j][2] * w[2] + z.v[j][3] * w[3]); }
                lg[e] = a; __builtin_amdgcn_sched_barrier(0); }
            {
                const bool b0 = lane & 1, b1 = lane & 2, b2 = lane & 4;
                float t4[4], t2[2], t1;
#pragma unroll
                for (int i = 0; i < 4; ++i) { const float keep = b0 ? lg[4 + i] : lg[i], send = b0 ? lg[i] : lg[4 + i]; t4[i] = keep + shx(send, 1); }
#pragma unroll
                for (int i = 0; i < 2; ++i) { const float keep = b1 ? t4[2 + i] : t4[i], send = b1 ? t4[i] : t4[2 + i]; t2[i] = keep + shx(send, 2); }
                { const float keep = b2 ? t2[1] : t2[0], send = b2 ? t2[0] : t2[1]; t1 = keep + shx(send, 4); }
                t1 += shx(t1, 8); t1 += shx(t1, 16); t1 += shx(t1, 32);
#pragma unroll
                for (int e = 0; e < 8; ++e) lg[e] = __uint_as_float((unsigned)__builtin_amdgcn_readlane((int)__float_as_uint(t1), (e >> 2) + 2 * ((e >> 1) & 1) + 4 * (e & 1))) + br_[e];
            }
            int e0 = 0; float v0 = lg[0];
#pragma unroll
            for (int e = 1; e < 8; ++e) if (lg[e] > v0) { v0 = lg[e]; e0 = e; }
            int e1 = -1; float v1 = -INFINITY;
#pragma unroll
            for (int e = 0; e < 8; ++e) if (e != e0 && lg[e] > v1) { v1 = lg[e]; e1 = e; }
            const float g0 = 1.0f / (1.0f + __expf(v1 - v0)), g1 = 1.0f - g0;
            if (lane == 0) { r_exp[2 * m] = e0; r_exp[2 * m + 1] = e1; r_gate[2 * m] = g0; r_gate[2 * m + 1] = g1; }
#pragma unroll
            for (int e = 0; e < 8; ++e) cnt[e] += (e == e0) + (e == e1);
        }
        {
            LAS int* wc = (LAS int*)lds;
            if (lane == 0) {
#pragma unroll
                for (int e = 0; e < 8; ++e) wc[wave * 8 + e] = cnt[e]; }
            __syncthreads();
            if (tid < 8) { int t = 0;
#pragma unroll
                for (int w = 0; w < 8; ++w) t += wc[w * 8 + tid];
                wgcnt[vcu * 8 + tid] = t; }
            __syncthreads();
        }
    }
    SEAM(16);

    int ecnt0 = 0, ecnt1 = 0, ecnt2 = 0, ecnt3 = 0, ecnt4 = 0, ecnt5 = 0, ecnt6 = 0, ecnt7 = 0, epre0 = 0, epre1 = 0, epre2 = 0, epre3 = 0, epre4 = 0, epre5 = 0, epre6 = 0, epre7 = 0;
    int ets0 = 0, ets1 = 0, ets2 = 0, ets3 = 0, ets4 = 0, ets5 = 0, ets6 = 0, ets7 = 0, ets8 = 0;
#define FOR_E(X) X(0, 1) X(1, 2) X(2, 3) X(3, 4) X(4, 5) X(5, 6) X(6, 7) X(7, 8)
    if (hi > 17) {
        LAS int* red = (LAS int*)lds;
        const int tid_ = wave * 64 + lane_id();
        if (tid_ < 16) red[tid_] = 0;
        __syncthreads();
        { const int wg = tid_ >> 1, hf = tid_ & 1; const int* c = wgcnt + wg * 8 + hf * 4; const bool ahead = wg < vcu;
#pragma unroll
            for (int j = 0; j < 4; ++j) { const int cv = c[j]; __hip_atomic_fetch_add(red + hf * 4 + j, cv, __ATOMIC_RELAXED, __HIP_MEMORY_SCOPE_WORKGROUP);
                if (ahead) __hip_atomic_fetch_add(red + 8 + hf * 4 + j, cv, __ATOMIC_RELAXED, __HIP_MEMORY_SCOPE_WORKGROUP); } }
        __syncthreads();
#define X_(E_, N_) ecnt##E_ = red[E_]; epre##E_ = red[8 + E_]; ets##N_ = ets##E_ + (ecnt##E_ + 255) / 256;
        FOR_E(X_)
#undef X_
        if (tid_ == 0) { MISC[16] = (unsigned)ets1; MISC[17] = (unsigned)ets2; MISC[18] = (unsigned)ets3; MISC[19] = (unsigned)ets4; MISC[20] = (unsigned)ets5; MISC[21] = (unsigned)ets6; MISC[22] = (unsigned)ets7; MISC[23] = (unsigned)ets8; }
        __syncthreads();
    }

    if (IN(17)) { const int lane = lane_id(); const int tid = wave * 64 + lane; (void)tid;
        {   const int blk = gw;
            const bool actl = lane < 16; const int m = blk * 16 + (lane & 15);
            const int e0 = actl ? r_exp[2 * m] : -1, e1 = actl ? r_exp[2 * m + 1] : -1;
            LAS int* wc = (LAS int*)lds;
            unsigned long long b0m[8], b1m[8];
#pragma unroll
            for (int e = 0; e < 8; ++e) { b0m[e] = __ballot(e0 == e); b1m[e] = __ballot(e1 == e); }
            if (lane == 0) {
#pragma unroll
                for (int e = 0; e < 8; ++e) wc[wave * 8 + e] = __popcll(b0m[e]) + __popcll(b1m[e]); }
            __syncthreads();
            int d0 = 0, d1 = 0; const unsigned long long below = (1ull << lane) - 1ull;
#define X_(E_, N_) { int base = ets##E_ * 256 + epre##E_; for (int w = 0; w < wave; ++w) base += wc[w * 8 + E_]; const int c0 = __popcll(b0m[E_]); \
                if (e0 == E_) d0 = base + __popcll(b0m[E_] & below); if (e1 == E_) d1 = base + c0 + __popcll(b1m[E_] & below); }
            FOR_E(X_)
#undef X_
            if (actl) { r_dest[2 * m] = d0; r_dest[2 * m + 1] = d1; }
#pragma unroll
            for (int i = 0; i < 16; ++i) {
                const int dd0 = __builtin_amdgcn_readlane(d0, i), dd1 = __builtin_amdgcn_readlane(d1, i);
                const u32x4 a = *((const u32x4*)(H3B + (size_t)(blk * 16 + i) * 1024) + lane);
                *((u32x4*)(XPAD8 + (size_t)dd0 * 1024) + lane) = a; *((u32x4*)(XPAD8 + (size_t)dd1 * 1024) + lane) = a;
            }
            __syncthreads();
        }
        if (bx < 8) { int r0 = 0, r1 = 0;
#define X_(E_, N_) if (bx == E_) { r0 = ets##E_ * 256 + ecnt##E_; r1 = ets##N_ * 256; }
            FOR_E(X_)
#undef X_
            const u32x4 z = (u32x4){0u, 0u, 0u, 0u};
            for (int r = r0 + wave; r < r1; r += 8) *((u32x4*)(XPAD8 + (size_t)r * 1024) + lane) = z; }
    }
    SEAM(17);


#define MT_(k_) __builtin_amdgcn_readfirstlane((int)MISC[16 + (k_)])
#define MOE_ORDER(S_, c_, nN_) pg8::MoeOrder S_; { const int t0_ = (c_) * MOE_CHUNK_TILES; int nm_ = MT_(7) - t0_; nm_ = nm_ < 0 ? 0 : (nm_ > MOE_CHUNK_TILES ? MOE_CHUNK_TILES : nm_); \
        S_.S.init(nm_, (nN_), G, bx); S_.tile0 = t0_; S_.ts1 = MT_(0); S_.ts2 = MT_(1); S_.ts3 = MT_(2); S_.ts4 = MT_(3); S_.ts5 = MT_(4); S_.ts6 = MT_(5); S_.ts7 = MT_(6); }
#define MOE_UP(ph, c_) if (IN(ph)) { MOE_ORDER(S, c_, 2 * FFE / 256); pg8::Gemm g{XPAD8 + (size_t)(c_) * MOE_CHUNK_TILES * 256 * DM, W8GU, DM, DM, (size_t)2 * FFE * DM, nullptr, nullptr, 0}; \
        pg8::EpiSwiglu8F E{ACT8, FFE, 1.0f / 128.0f}; for (int rep = 0; rep < REP_UP; ++rep) pg8::gemm_phase<pg8::EpiSwiglu8F, pg8::MoeOrder, true>(lds, g, S, E, wave); } SEAM(ph);
#define MOE_DOWN(ph, c_) if (IN(ph)) { MOE_ORDER(S, c_, DM / 256); pg8::Gemm g{ACT8, W8D, FFE, FFE, (size_t)DM * FFE, nullptr, nullptr, 0}; \
        pg8::EpiPlainS E{YPAD + (size_t)(c_) * MOE_CHUNK_TILES * 256 * DM, DM, 1.0f / 1024.0f}; for (int rep = 0; rep < REP_DOWN; ++rep) pg8::gemm_phase<pg8::EpiPlainS, pg8::MoeOrder, true>(lds, g, S, E, wave); } SEAM(ph);
    MOE_UP(19, 0) MOE_DOWN(20, 0) MOE_UP(21, 1) MOE_DOWN(22, 1) MOE_UP(23, 2) MOE_DOWN(24, 2)
    static_assert(MOE_CHUNKS == 3, "chunk phases");

    if (IN(29)) { const int lane = lane_id(); const int tid = wave * 64 + lane; (void)tid;
        const Row16 LG = ld_row_f32(PRM(P_LN2G) + DM, lane), LB = ld_row_f32(PRM(P_LN2B) + DM, lane);
        struct RowG { f32x4 x[4]; u32x2 ya[4], yb[4]; };
        int d0v = 0, d1v = 0; float g0v = 0.f, g1v = 0.f;
        if (lane < MS / NGW) { const int ml = gw + lane * NGW; d0v = r_dest[2 * ml]; d1v = r_dest[2 * ml + 1]; g0v = r_gate[2 * ml]; g1v = r_gate[2 * ml + 1]; }
#define P29_ALD(Q, m_) do { const int ml = ((m_) < hi) ? (m_) : m0; const int k_ = (ml - gw) / NGW; const int D0 = __builtin_amdgcn_readlane(d0v, k_), D1 = __builtin_amdgcn_readlane(d1v, k_); \
            const f32x4* q_ = (const f32x4*)(out + (size_t)ml * DM) + lane; const u32x2* a_ = (const u32x2*)(YPAD + (size_t)D0 * DM) + lane; const u32x2* b_ = (const u32x2*)(YPAD + (size_t)D1 * DM) + lane; \
            asm volatile("global_load_dwordx4 %0, %4, off\n\tglobal_load_dwordx4 %1, %4, off offset:1024\n\tglobal_load_dwordx4 %2, %4, off offset:2048\n\tglobal_load_dwordx4 %3, %4, off offset:3072" \
                         : "=&v"(Q.x[0]), "=&v"(Q.x[1]), "=&v"(Q.x[2]), "=&v"(Q.x[3]) : "v"(q_) : "memory"); \
            asm volatile("global_load_dwordx2 %0, %4, off\n\tglobal_load_dwordx2 %1, %4, off offset:512\n\tglobal_load_dwordx2 %2, %4, off offset:1024\n\tglobal_load_dwordx2 %3, %4, off offset:1536" \
                         : "=&v"(Q.ya[0]), "=&v"(Q.ya[1]), "=&v"(Q.ya[2]), "=&v"(Q.ya[3]) : "v"(a_) : "memory"); \
            asm volatile("global_load_dwordx2 %0, %4, off\n\tglobal_load_dwordx2 %1, %4, off offset:512\n\tglobal_load_dwordx2 %2, %4, off offset:1024\n\tglobal_load_dwordx2 %3, %4, off offset:1536" \
                         : "=&v"(Q.yb[0]), "=&v"(Q.yb[1]), "=&v"(Q.yb[2]), "=&v"(Q.yb[3]) : "v"(b_) : "memory"); } while (0)
#define P29_WAIT(N, Q) asm volatile("s_waitcnt vmcnt(" #N ")" : "+v"(Q.x[0]), "+v"(Q.x[1]), "+v"(Q.x[2]), "+v"(Q.x[3]), "+v"(Q.ya[0]), "+v"(Q.ya[1]), "+v"(Q.ya[2]), "+v"(Q.ya[3]), "+v"(Q.yb[0]), "+v"(Q.yb[1]), "+v"(Q.yb[2]), "+v"(Q.yb[3]) :: "memory")
#define P29_ROW(Q, m_) do { const int mm = (m_); const int k_ = (mm - gw) / NGW; \
            const float G0 = __uint_as_float((unsigned)__builtin_amdgcn_readlane((int)__float_as_uint(g0v), k_)), G1 = __uint_as_float((unsigned)__builtin_amdgcn_readlane((int)__float_as_uint(g1v), k_)); Row16 z; \
            _Pragma("unroll") for (int j = 0; j < 4; ++j) z.v[j] = Q.x[j] * ALPHA + GT.v[j] * (G0 * bf4(Q.ya[j]) + G1 * bf4(Q.yb[j])); \
            ln_row2(z, LG, LB); \
            st_row_f32(out + (size_t)mm * DM, lane, z); } while (0)
        for (int seg = 0; seg < 2; ++seg) {
            const int lo = seg * SEQ, hi = lo + SEQ;
            int m = lo + ((gw - lo % NGW + NGW) % NGW);
            if (m >= hi) continue;
            const int m0 = m; RowG qa, qb, qc;
            P29_ALD(qa, m); P29_ALD(qb, m + NGW); P29_ALD(qc, m + 2 * NGW);
            const Row16 GT = ld_row_f32(mods + (size_t)(1 * 3 + seg) * 6144 + 5 * 1024, lane);
            P29_WAIT(24, qa); P29_ROW(qa, m); P29_ALD(qa, m + 3 * NGW);
            if (m + NGW < hi) { P29_WAIT(28, qb); P29_ROW(qb, m + NGW); P29_ALD(qb, m + 4 * NGW); }
            if (m + 2 * NGW < hi) { P29_WAIT(32, qc); P29_ROW(qc, m + 2 * NGW); P29_ALD(qc, m + 5 * NGW); }
            for (m += 3 * NGW; m < hi; m += 3 * NGW) {
                P29_WAIT(32, qa); P29_ROW(qa, m); P29_ALD(qa, m + 3 * NGW);
                if (m + NGW < hi) { P29_WAIT(32, qb); P29_ROW(qb, m + NGW); P29_ALD(qb, m + 4 * NGW); }
                if (m + 2 * NGW < hi) { P29_WAIT(32, qc); P29_ROW(qc, m + 2 * NGW); P29_ALD(qc, m + 5 * NGW); }
            }
            P29_WAIT(0, qa); P29_WAIT(0, qb); P29_WAIT(0, qc);
        }
#undef P29_ROW
#undef P29_WAIT
#undef P29_ALD
    }
#undef IN
#undef SEAM
#undef G
#undef bx
#undef vcu
#undef gw
#undef NGW
#undef PRM
#undef out
#undef x_in
#undef ctx_in
#undef mods
}

extern "C" void kernel_launch(void* const* d_in, const int* in_sizes, int n_in, void* d_out, int out_size, void* d_ws, size_t ws_size, hipStream_t stream) {
    static int grid = 0;
    if (grid == 0) {
        if (n_in != N_INPUTS || ws_size < WS_END) { fprintf(stderr, "kernel_launch: unexpected n_in %d / ws %zu\n", n_in, ws_size); grid = -1; return; }
        int dev = 0, cus = 0, per_cu = 0;
        if (hipGetDevice(&dev) != hipSuccess || hipDeviceGetAttribute(&cus, hipDeviceAttributeMultiprocessorCount, dev) != hipSuccess) { grid = -1; return; }
        if (hipFuncSetAttribute((const void*)fwd_kernel, hipFuncAttributeMaxDynamicSharedMemorySize, LDS_BYTES) != hipSuccess) { grid = -1; return; }
        if (hipOccupancyMaxActiveBlocksPerMultiprocessor(&per_cu, (const void*)fwd_kernel, 512, LDS_BYTES) != hipSuccess || per_cu < 1)
            fprintf(stderr, "kernel_launch: occupancy query reports %d workgroups per CU\n", per_cu);
        (void)hipGetLastError();
        grid = cus;
        if (grid != 256) fprintf(stderr, "kernel_launch: %d CUs (the unit maps assume 256)\n", grid);
    }
    if (grid < 0) return;
    (void)hipMemsetAsync((char*)d_ws + WS_CTL, 0, CTL_ZERO_BYTES, stream);
    Args a{};
    for (int i = 0; i < N_INPUTS; ++i) a.in[i] = (const float*)d_in[i];
    a.out = (float*)d_out; a.ws = (unsigned char*)d_ws;
#if MK_PER_PHASE
    for (int p = 0; p <= N_PHASES; ++p) { a.ph_lo = p; a.ph_hi = p + 1; hipLaunchKernelGGL(fwd_kernel, dim3(grid), dim3(512), LDS_BYTES, stream, a); }
#else
#if PROBE_K > 0
    a.ph_lo = 0; a.ph_hi = PROBE_K;
    hipLaunchKernelGGL(fwd_kernel, dim3(grid), dim3(512), LDS_BYTES, stream, a);
    (void)hipMemsetAsync((char*)d_ws + WS_CTL, 0, CTL_ZERO_BYTES, stream);
#endif
    a.ph_lo = 0; a.ph_hi = N_PHASES + 1;
    hipLaunchKernelGGL(fwd_kernel, dim3(grid), dim3(512), LDS_BYTES, stream, a);
#endif
}
```

```cpp
#include <hip/hip_runtime.h>
#include <cstdio>
#include <cstdint>

#ifndef MK_PER_PHASE
#define MK_PER_PHASE 0
#endif
#ifndef REP_A0
#define REP_A0 1
#endif
#ifndef REP_A1
#define REP_A1 1
#endif
#ifndef REP_NA
#define REP_NA 1
#endif
#ifndef REP_POOL
#define REP_POOL 1
#endif
#ifndef REP_P3
#define REP_P3 1
#endif
#ifndef REP_UP
#define REP_UP 1
#endif
#ifndef REP_DOWN
#define REP_DOWN 1
#endif
#ifndef REP_G
#define REP_G 1
#endif
#ifndef PROBE_K
#define PROBE_K 0
#endif

#define LAS __attribute__((address_space(3)))
#define GAS __attribute__((address_space(1)))
typedef unsigned short bf16;
typedef short bf16x8 __attribute__((ext_vector_type(8)));
typedef short v4i16_t __attribute__((ext_vector_type(4)));
typedef float f32x4 __attribute__((ext_vector_type(4)));
typedef float f32x2 __attribute__((ext_vector_type(2)));
typedef float f32x16 __attribute__((ext_vector_type(16)));
typedef unsigned u32x4 __attribute__((ext_vector_type(4)));
typedef unsigned u32x2 __attribute__((ext_vector_type(2)));
typedef GAS unsigned gu32;
#define RLX_AGENT __ATOMIC_RELAXED, __HIP_MEMORY_SCOPE_AGENT
#define LDS_WAIT() asm volatile("s_waitcnt lgkmcnt(0)" ::: "memory")
#define VM_WAIT() asm volatile("s_waitcnt vmcnt(0)" ::: "memory")

constexpr int DM = 1024, SEQ = 16384, MS = 32768, MC = 512, MA = MS + MC, CTX = 256, NKEY = CTX + SEQ;
constexpr int FF0 = 2816, FFE = 3584, NEXP = 8;
constexpr int N_IN0 = 1536, N_IN1 = 2304;
constexpr int C1_CQ = 0, C1_CKV = 384, C1_NQ = 640, C1_NK = 1152, C1_NV = 1664, C1_KR = 2176;
constexpr float LOG2E = 1.4426950408889634f;
constexpr float SC64 = 0.125f * LOG2E;
constexpr float SC96 = 0.10206207261596577f * LOG2E;
constexpr float ALPHA = 1.4142135623730951f;
constexpr float EPS = 1e-6f;
constexpr int MOE_TILES = 264, MOE_CHUNK_TILES = 128, MOE_CHUNKS = 2;

__device__ __forceinline__ float bf2f(unsigned short h) { return __uint_as_float((unsigned)h << 16); }
__device__ __forceinline__ unsigned f2bf(float f) { unsigned u = __float_as_uint(f); return (u + 0x7fffu + ((u >> 16) & 1u)) >> 16; }
__device__ __forceinline__ unsigned pk2(float lo, float hi) { return f2bf(lo) | (f2bf(hi) << 16); }
__device__ __forceinline__ unsigned cvt_pk_bf16(float lo, float hi) { unsigned r; asm volatile("v_cvt_pk_bf16_f32 %0, %1, %2" : "=v"(r) : "v"(lo), "v"(hi)); return r; }
__device__ __forceinline__ int lane_id() { int l; asm volatile("v_mbcnt_lo_u32_b32 %0, -1, 0\n\tv_mbcnt_hi_u32_b32 %0, -1, %0" : "=v"(l)); return l; }
__device__ __forceinline__ float shx(float v, int o) { const int l = lane_id(); return __uint_as_float((unsigned)__builtin_amdgcn_ds_bpermute((l ^ o) << 2, (int)__float_as_uint(v))); }

#define DPPF(v_, ctrl_) __builtin_bit_cast(float, __builtin_amdgcn_update_dpp(0, __builtin_bit_cast(int, (v_)), (ctrl_), 0xF, 0xF, true))
__device__ __forceinline__ float wave_max(float v) {
    v = fmaxf(v, DPPF(v, 0xB1)); v = fmaxf(v, DPPF(v, 0x4E)); v = fmaxf(v, DPPF(v, 0x141)); v = fmaxf(v, DPPF(v, 0x140));
    v = fmaxf(v, shx(v, 16)); v = fmaxf(v, shx(v, 32));
    return v;
}
__device__ __forceinline__ float wave_sum(float v) {
    v += DPPF(v, 0xB1); v += DPPF(v, 0x4E); v += DPPF(v, 0x141); v += DPPF(v, 0x140);
    v += shx(v, 16); v += shx(v, 32);
    return v;
}
__device__ __forceinline__ int kvrow(int m) {
    if (m < MS) { const int b = m >> 14, t = m & (SEQ - 1); return b * NKEY + CTX + t; }
    const int r = m - MS; return (r >> 8) * NKEY + (r & 255);
}
__device__ __forceinline__ size_t k1off(int kv, int h) {
    return (size_t)(kv + ((kv >= NKEY ? 7 : 0) + h) * NKEY) * 128;
}

namespace pg8 {
constexpr int BM = 256, BK = 64, HALF = 128, HTB = HALF * BK * 2, STAGE_BYTES = 8 * HTB, NXCD = 8, WGM = 8;
__host__ __device__ __forceinline__ int lds_byte(int r, int c) { const int st = (r >> 4) * 2 + (c >> 5), rr = r & 15, cc = c & 31, ob = rr * 64 + cc * 2; return st * 1024 + (ob ^ (((ob >> 9) & 1) << 5)); }
__host__ __device__ __forceinline__ void stage_rc(int b, int& R, int& C) { const int st = b / 1024, sb = b % 1024, swz = sb ^ (((sb >> 9) & 1) << 5); R = (st >> 1) * 16 + swz / 64; C = (st & 1) * 32 + (swz % 64) / 2; }
__host__ __device__ __forceinline__ int perm32(int rho) { const int n = rho >> 4, i = rho & 15; return 8 * (i >> 2) + 4 * n + (i & 3); }

struct Unit { int pm, pn, e; };
struct Gemm { const void* A; const void* Bt; int K; int lda; size_t estride;
    const float* qa; const float* qw; int qwstride; };
typedef int i32x4v __attribute__((ext_vector_type(4))); typedef int i32x8v __attribute__((ext_vector_type(8)));
struct Frag2 { bf16x8 k[2]; };
template <int MODE> struct FragT { typedef Frag2 A; };
template <> struct FragT<1> { typedef i32x8v A; };

struct StaticOrder {
    int nM, nN, nwg, G, c;
    __device__ void init(int nM_, int nN_, int G_, int c_) { nM = nM_; nN = nN_; nwg = nM * nN; G = G_; c = c_; }
    __device__ bool next(int i, Unit& u) const {
        const long L = (long)i * G + c; if (L >= nwg) return false;
        int wgid = (int)L; { const int q = nwg / NXCD, r = nwg % NXCD, xcd = wgid % NXCD, off = wgid / NXCD; wgid = (xcd < r ? xcd * (q + 1) : r * (q + 1) + (xcd - r) * q) + off; }
        const int nig = WGM * nN, gid = wgid / nig, fm = gid * WGM, gsz = (nM - fm) < WGM ? (nM - fm) : WGM;
        u.pm = fm + ((wgid % nig) % gsz); u.pn = (wgid % nig) / gsz; u.e = 0; return true;
    }
};
struct MoeOrder {
    StaticOrder S; int tile0; int ts1, ts2, ts3, ts4, ts5, ts6, ts7;
    __device__ bool next(int i, Unit& u) const {
        if (!S.next(i, u)) return false;
        const int g = tile0 + u.pm;
        u.e = (g >= ts1) + (g >= ts2) + (g >= ts3) + (g >= ts4) + (g >= ts5) + (g >= ts6) + (g >= ts7);
        return true;
    }
};

struct EpiPlain {
    static constexpr bool PERM = true;
    bf16* O; int ldc;
    __device__ __forceinline__ void operator()(const f32x4 (&acc)[2][2][4][2], const Unit& u, int wr, int wc, int fr, int fq) const {
        const int row0 = u.pm * BM + wr * 64 + fr, col0 = u.pn * BM + wc * 32 + 8 * fq;
#pragma unroll
        for (int ai = 0; ai < 2; ++ai)
#pragma unroll
            for (int m = 0; m < 4; ++m) { bf16* rowp = O + (size_t)(row0 + ai * HALF + m * 16) * ldc + col0;
#pragma unroll
                for (int bj = 0; bj < 2; ++bj) { const f32x4 v0 = acc[ai][bj][m][0], v1 = acc[ai][bj][m][1];
                    u32x4 w; w.x = cvt_pk_bf16(v0[0], v0[1]); w.y = cvt_pk_bf16(v0[2], v0[3]); w.z = cvt_pk_bf16(v1[0], v1[1]); w.w = cvt_pk_bf16(v1[2], v1[3]);
                    *(u32x4*)(rowp + bj * HALF) = w; } }
    }
};
struct EpiPlainS {
    static constexpr bool PERM = true;
    bf16* O; int ldc; float osc;
    __device__ __forceinline__ void operator()(const f32x4 (&acc)[2][2][4][2], const Unit& u, int wr, int wc, int fr, int fq) const {
        const int row0 = u.pm * BM + wr * 64 + fr, col0 = u.pn * BM + wc * 32 + 8 * fq;
#pragma unroll
        for (int ai = 0; ai < 2; ++ai)
#pragma unroll
            for (int m = 0; m < 4; ++m) { bf16* rowp = O + (size_t)(row0 + ai * HALF + m * 16) * ldc + col0;
#pragma unroll
                for (int bj = 0; bj < 2; ++bj) { const f32x4 v0 = acc[ai][bj][m][0] * osc, v1 = acc[ai][bj][m][1] * osc;
                    u32x4 w; w.x = cvt_pk_bf16(v0[0], v0[1]); w.y = cvt_pk_bf16(v0[2], v0[3]); w.z = cvt_pk_bf16(v1[0], v1[1]); w.w = cvt_pk_bf16(v1[2], v1[3]);
                    *(u32x4*)(rowp + bj * HALF) = w; } }
    }
};
struct EpiSwiglu {
    static constexpr bool PERM = true;
    bf16* O; int ldc; float isc;
    __device__ __forceinline__ void operator()(const f32x4 (&acc)[2][2][4][2], const Unit& u, int wr, int wc, int fr, int fq) const {
        const int row0 = u.pm * BM + wr * 64 + fr, col0 = u.pn * HALF + wc * 32 + 8 * fq;
#pragma unroll
        for (int ai = 0; ai < 2; ++ai)
#pragma unroll
            for (int m = 0; m < 4; ++m) { bf16* rowp = O + (size_t)(row0 + ai * HALF + m * 16) * ldc + col0;
                float r[8];
#pragma unroll
                for (int n = 0; n < 2; ++n)
#pragma unroll
                    for (int j = 0; j < 4; ++j) { const float g = acc[ai][0][m][n][j] * isc, up = acc[ai][1][m][n][j] * isc;
                        const float s = __builtin_amdgcn_rcpf(1.0f + __builtin_amdgcn_exp2f(-g * LOG2E));
                        r[n * 4 + j] = g * s * up; }
                u32x4 w; w.x = cvt_pk_bf16(r[0], r[1]); w.y = cvt_pk_bf16(r[2], r[3]); w.z = cvt_pk_bf16(r[4], r[5]); w.w = cvt_pk_bf16(r[6], r[7]);
                *(u32x4*)rowp = w; }
    }
};
struct EpiQKV {
    static constexpr bool PERM = false;
    unsigned char* wsb; size_t oq, ok, ov, op, oc; const float* qg; const float* kg;
    __device__ __forceinline__ void operator()(const f32x4 (&acc)[2][2][4][2], const Unit& u, int wr, int wc, int fr, int fq) const {
        const int row0 = u.pm * BM + wr * 64 + fr;
        if (u.pn < 4) {
            const bool isq = u.pn < 3, rope = u.pm < MS / BM;
            unsigned char* Qp = wsb + oq; unsigned char* Kp = wsb + ok; const float* ct = (const float*)(wsb + oc); const float* st = ct + 4096;
            const float* gv = isq ? qg : kg;
            f32x4 gn[2][2];
#pragma unroll
            for (int bj = 0; bj < 2; ++bj)
#pragma unroll
                for (int n = 0; n < 2; ++n) gn[bj][n] = *(const f32x4*)(gv + bj * 32 + 16 * n + 4 * fq);
            const float osc = isq ? SC64 * 8.0f : 1.0f;
#pragma unroll
            for (int ai = 0; ai < 2; ++ai)
#pragma unroll
                for (int m = 0; m < 4; ++m) {
                    const int row = row0 + ai * HALF + m * 16;
                    float ss = 0.f;
#pragma unroll
                    for (int bj = 0; bj < 2; ++bj)
#pragma unroll
                        for (int n = 0; n < 2; ++n) { const f32x4 v = acc[ai][bj][m][n]; ss += (v[0] * v[0] + v[1] * v[1]) + (v[2] * v[2] + v[3] * v[3]); }
                    ss += shx(ss, 16); ss += shx(ss, 32);
                    const float rstd = osc / sqrtf(ss * (1.f / 64.f) + EPS);
                    const int t = row & (SEQ - 1);
                    unsigned char* dst = isq ? Qp + (size_t)row * 768 + (u.pn * 4 + wc) * 64 + 4 * fq : Kp + (size_t)(kvrow(row) + ((kvrow(row) >= NKEY ? 3 : 0) + wc) * NKEY) * 64 + 4 * fq;
#pragma unroll
                    for (int bj = 0; bj < 2; ++bj) {
                        const int pos = bj ? (t & 63) : (t >> 6);
                        f32x4 cs = (f32x4){1.f, 1.f, 1.f, 1.f}, sn = (f32x4){0.f, 0.f, 0.f, 0.f};
                        if (rope) { cs = *(const f32x4*)(ct + pos * 16 + 4 * fq); sn = *(const f32x4*)(st + pos * 16 + 4 * fq); }
                        const f32x4 x1 = acc[ai][bj][m][0] * rstd * gn[bj][0], x2 = acc[ai][bj][m][1] * rstd * gn[bj][1];
                        const f32x4 o1 = x1 * cs - x2 * sn, o2 = x1 * sn + x2 * cs;
                        int w1 = 0, w2 = 0; w1 = __builtin_amdgcn_cvt_pk_fp8_f32(o1[0], o1[1], w1, false); w1 = __builtin_amdgcn_cvt_pk_fp8_f32(o1[2], o1[3], w1, true);
                        w2 = __builtin_amdgcn_cvt_pk_fp8_f32(o2[0], o2[1], w2, false); w2 = __builtin_amdgcn_cvt_pk_fp8_f32(o2[2], o2[3], w2, true);
                        *(int*)(dst + bj * 32) = w1; *(int*)(dst + bj * 32 + 16) = w2; }
                }
        } else {
            const bool isv = u.pn == 4; bf16* Vp = (bf16*)(wsb + ov); bf16* Pp = (bf16*)(wsb + op);
#pragma unroll
            for (int ai = 0; ai < 2; ++ai)
#pragma unroll
                for (int m = 0; m < 4; ++m) {
                    const int row = row0 + ai * HALF + m * 16;
                    bf16* dst = (isv ? Vp + (size_t)kvrow(row) * 256 : Pp + (size_t)row * 256) + wc * 32 + 4 * fq;
#pragma unroll
                    for (int bj = 0; bj < 2; ++bj)
#pragma unroll
                        for (int n = 0; n < 2; ++n) { const f32x4 v = acc[ai][bj][m][n]; u32x2 w; w.x = cvt_pk_bf16(v[0], v[1]); w.y = cvt_pk_bf16(v[2], v[3]); *(u32x2*)(dst + bj * HALF + 16 * n) = w; }
                }
        }
    }
};
struct EpiSwiglu8 {
    static constexpr bool PERM = true;
    unsigned char* O; int ldc; float isc;
    __device__ __forceinline__ void operator()(const f32x4 (&acc)[2][2][4][2], const Unit& u, int wr, int wc, int fr, int fq) const {
        const int row0 = u.pm * BM + wr * 64 + fr, col0 = u.pn * HALF + wc * 32 + 8 * fq;
#pragma unroll
        for (int ai = 0; ai < 2; ++ai)
#pragma unroll
            for (int m = 0; m < 4; ++m) { unsigned char* rowp = O + (size_t)(row0 + ai * HALF + m * 16) * ldc + col0;
                float r[8];
#pragma unroll
                for (int n = 0; n < 2; ++n)
#pragma unroll
                    for (int j = 0; j < 4; ++j) { const float g = acc[ai][0][m][n][j] * isc, up = acc[ai][1][m][n][j] * isc;
                        const float s = __builtin_amdgcn_rcpf(1.0f + __builtin_amdgcn_exp2f(-g * LOG2E));
                        r[n * 4 + j] = g * s * up * 8.0f; }
                int w0 = 0, w1 = 0; w0 = __builtin_amdgcn_cvt_pk_fp8_f32(r[0], r[1], w0, false); w0 = __builtin_amdgcn_cvt_pk_fp8_f32(r[2], r[3], w0, true);
                w1 = __builtin_amdgcn_cvt_pk_fp8_f32(r[4], r[5], w1, false); w1 = __builtin_amdgcn_cvt_pk_fp8_f32(r[6], r[7], w1, true);
                u32x2 w; w.x = (unsigned)w0; w.y = (unsigned)w1; *(u32x2*)rowp = w; }
    }
};
struct EpiSwiglu8F {
    static constexpr bool PERM = true;
    unsigned char* O; int ldc; float isc;
    __device__ __forceinline__ void operator()(const f32x4 (&acc)[2][2][4][2], const Unit& u, int wr, int wc, int fr, int fq) const {
        const int row0 = u.pm * BM + wr * 64 + fr, col0 = u.pn * HALF + wc * 32 + 8 * fq;
        const float c1 = -isc * LOG2E, c2 = 8.0f * isc * isc;
#pragma unroll
        for (int ai = 0; ai < 2; ++ai)
#pragma unroll
            for (int m = 0; m < 4; ++m) { unsigned char* rowp = O + (size_t)(row0 + ai * HALF + m * 16) * ldc + col0;
                float r[8];
#pragma unroll
                for (int n = 0; n < 2; ++n)
#pragma unroll
                    for (int j = 0; j < 4; ++j) { const float ag = acc[ai][0][m][n][j], au = acc[ai][1][m][n][j];
                        const float s = __builtin_amdgcn_rcpf(1.0f + __builtin_amdgcn_exp2f(ag * c1));
                        r[n * 4 + j] = (ag * au) * (s * c2); }
                int w0 = 0, w1 = 0; w0 = __builtin_amdgcn_cvt_pk_fp8_f32(r[0], r[1], w0, false); w0 = __builtin_amdgcn_cvt_pk_fp8_f32(r[2], r[3], w0, true);
                w1 = __builtin_amdgcn_cvt_pk_fp8_f32(r[4], r[5], w1, false); w1 = __builtin_amdgcn_cvt_pk_fp8_f32(r[6], r[7], w1, true);
                u32x2 w; w.x = (unsigned)w0; w.y = (unsigned)w1; *(u32x2*)rowp = w; }
    }
};
struct EpiKV {
    static constexpr bool PERM = true;
    unsigned char* K1p; bf16* V1p;
    __device__ __forceinline__ void operator()(const f32x4 (&acc)[2][2][4][2], const Unit& u, int wr, int wc, int fr, int fq) const {
        const int row0 = u.pm * BM + wr * 64 + fr;
        if (u.pn < 2) {
#pragma unroll
            for (int ai = 0; ai < 2; ++ai)
#pragma unroll
                for (int m = 0; m < 4; ++m) { const int kv_ = kvrow(row0 + ai * HALF + m * 16);
#pragma unroll
                    for (int bj = 0; bj < 2; ++bj) { const f32x4 v0 = acc[ai][bj][m][0], v1 = acc[ai][bj][m][1];
                        int w0 = 0, w1 = 0; w0 = __builtin_amdgcn_cvt_pk_fp8_f32(v0[0], v0[1], w0, false); w0 = __builtin_amdgcn_cvt_pk_fp8_f32(v0[2], v0[3], w0, true);
                        w1 = __builtin_amdgcn_cvt_pk_fp8_f32(v1[0], v1[1], w1, false); w1 = __builtin_amdgcn_cvt_pk_fp8_f32(v1[2], v1[3], w1, true);
                        u32x2 w; w.x = (unsigned)w0; w.y = (unsigned)w1;
                        *(u32x2*)(K1p + k1off(kv_, u.pn * 4 + bj * 2 + (wc >> 1)) + (unsigned)((wc & 1) * 32 + 8 * fq)) = w; } }
        } else {
#pragma unroll
            for (int ai = 0; ai < 2; ++ai)
#pragma unroll
                for (int m = 0; m < 4; ++m) { const unsigned kr = (unsigned)kvrow(row0 + ai * HALF + m * 16) * 512u;
#pragma unroll
                    for (int bj = 0; bj < 2; ++bj) { const f32x4 v0 = acc[ai][bj][m][0], v1 = acc[ai][bj][m][1];
                        u32x4 w; w.x = cvt_pk_bf16(v0[0], v0[1]); w.y = cvt_pk_bf16(v0[2], v0[3]); w.z = cvt_pk_bf16(v1[0], v1[1]); w.w = cvt_pk_bf16(v1[2], v1[3]);
                        *(u32x4*)(V1p + (kr + (unsigned)((u.pn - 2) * BM + bj * HALF + wc * 32 + 8 * fq))) = w; } }
        }
    }
};

__device__ __forceinline__ const char* uni_ptr(const char* p) {
    const unsigned lo = __builtin_amdgcn_readfirstlane((unsigned)(uintptr_t)p), hi = __builtin_amdgcn_readfirstlane((unsigned)((uintptr_t)p >> 32));
    return (const char*)(((uintptr_t)hi << 32) | lo); }
template <class Epi, class Sched, int MODE = 0>
__device__ __forceinline__ void gemm_phase(LAS unsigned char* lds, const Gemm g, const Sched& S, const Epi& E, const int wid) {
    constexpr bool F8 = (MODE == 1), I8 = (MODE == 2); constexpr int EB = MODE ? 1 : 2;
    const int lane = lane_id(), tid = wid * 64 + lane, wr = wid >> 2, wc = wid & 3, fr = lane & 15, fq = lane >> 4;
    int K_ = g.K; asm volatile("" : "+s"(K_));
    const int K = K_, nt = K * EB / (BK * 2), lda = g.lda;
    unsigned voffA[2], voffB[2];
#pragma unroll
    for (int i = 0; i < 2; ++i) { int R, C; stage_rc(tid * 16 + i * 8192, R, C); const int Rb = Epi::PERM ? ((R & ~31) + perm32(R & 31)) : R;
        voffA[i] = (unsigned)(R * lda * EB + C * 2); voffB[i] = (unsigned)(Rb * K * EB + C * 2); }
    const size_t kstep = (size_t)(BK * 2);
    const size_t hstepA = (size_t)HALF * lda * EB, tstepA = 2 * hstepA;
    const size_t hstepB = (size_t)HALF * K * EB, tstepB = 2 * hstepB;
    const unsigned ldsw = (unsigned)wid * 1024u;
    const int aoff = lds_byte(wr * 64 + fr, fq * 8), boff = lds_byte(wc * 32 + fr, fq * 8);
#define PG8_SA(b, h) (((b) * 2 + (h)) * HTB)
#define PG8_SB(b, h) ((4 + (b) * 2 + (h)) * HTB)
#define PG8_STAGE(bufoff, gbase, voff) do { const char* gb_ = (const char*)(gbase); asm volatile("" : "+s"(gb_));     \
        _Pragma("unroll") for (int _i = 0; _i < 2; ++_i) { unsigned vo_ = (voff)[_i]; asm volatile("" : "+v"(vo_));     \
        __builtin_amdgcn_global_load_lds((const unsigned*)(gb_ + vo_), (LAS unsigned*)(lds + (bufoff) + ldsw + _i * 8192), 16, 0, 0); } } while (0)
#define PG8_FR(dst, addr) do { const LAS unsigned char* p_ = (addr); if constexpr (F8) { const i32x4v lo_ = *(const LAS i32x4v*)p_, hi_ = *(const LAS i32x4v*)(p_ + 1024); *(i32x8v*)&(dst) = __builtin_shufflevector(lo_, hi_, 0, 1, 2, 3, 4, 5, 6, 7); } \
        else { ((Frag2*)&(dst))->k[0] = *(const LAS bf16x8*)p_; ((Frag2*)&(dst))->k[1] = *(const LAS bf16x8*)(p_ + 1024); } } while (0)
#define PG8_LDA(dst, b, h) do { _Pragma("unroll") for (int m = 0; m < 4; ++m) PG8_FR(dst[m], lds + PG8_SA(b, h) + aoff + m * 2048); } while (0)
#define PG8_LDB(dst, b, h) do { _Pragma("unroll") for (int n = 0; n < 2; ++n) PG8_FR(dst[n], lds + PG8_SB(b, h) + boff + n * 2048); } while (0)
#define PG8_MMA(ai, bj, At, Bt) do { __builtin_amdgcn_s_setprio(1); _Pragma("unroll") for (int m = 0; m < 4; ++m) _Pragma("unroll") for (int n = 0; n < 2; ++n) { \
        if constexpr (F8) acc[ai][bj][m][n] = __builtin_amdgcn_mfma_scale_f32_16x16x128_f8f6f4(*(const i32x8v*)&Bt[n], *(const i32x8v*)&At[m], acc[ai][bj][m][n], 0, 0, 0, 0, 0, 0); \
        else if constexpr (I8) { _Pragma("unroll") for (int k = 0; k < 2; ++k) acc[ai][bj][m][n] = __builtin_bit_cast(f32x4, __builtin_amdgcn_mfma_i32_16x16x64_i8(__builtin_bit_cast(i32x4v, ((const Frag2*)&Bt[n])->k[k]), __builtin_bit_cast(i32x4v, ((const Frag2*)&At[m])->k[k]), __builtin_bit_cast(i32x4v, acc[ai][bj][m][n]), 0, 0, 0)); } \
        else { _Pragma("unroll") for (int k = 0; k < 2; ++k) acc[ai][bj][m][n] = __builtin_amdgcn_mfma_f32_16x16x32_bf16(((const Frag2*)&Bt[n])->k[k], ((const Frag2*)&At[m])->k[k], acc[ai][bj][m][n], 0, 0, 0); } } \
        __builtin_amdgcn_s_setprio(0); } while (0)
#define PG8_WAIT_V(n) asm volatile("s_waitcnt vmcnt(" #n ")" ::: "memory")
#define PG8_WAIT_L(n) asm volatile("s_waitcnt lgkmcnt(" #n ")" ::: "memory")
#define PG8_BAR __builtin_amdgcn_s_barrier()
#define PG8_SCHED __builtin_amdgcn_sched_barrier(0)
    Unit cur, nxt; int ui = 0;
    if (!S.next(0, cur)) return;
    f32x4 acc[2][2][4][2];
#pragma unroll
    for (int a = 0; a < 2; ++a)
#pragma unroll
        for (int b = 0; b < 2; ++b)
#pragma unroll
            for (int m = 0; m < 4; ++m)
#pragma unroll
                for (int n = 0; n < 2; ++n) acc[a][b][m][n] = (f32x4){0.f, 0.f, 0.f, 0.f};
    typename FragT<MODE>::A At[4]; typename FragT<MODE>::A B0[2], B1[2];
    const char* cA = uni_ptr((const char*)g.A + (size_t)cur.pm * tstepA); const char* cB = uni_ptr((const char*)g.Bt + (size_t)cur.pn * tstepB + (size_t)cur.e * g.estride);
    PG8_STAGE(PG8_SB(0, 0), cB, voffB); PG8_STAGE(PG8_SB(0, 1), cB + hstepB, voffB); PG8_STAGE(PG8_SA(0, 0), cA, voffA); PG8_STAGE(PG8_SA(0, 1), cA + hstepA, voffA);
    if (wr == 1) PG8_BAR;
    PG8_WAIT_V(2); PG8_BAR;
    PG8_STAGE(PG8_SB(1, 0), cB + kstep, voffB); PG8_STAGE(PG8_SA(1, 0), cA + kstep, voffA); PG8_STAGE(PG8_SB(1, 1), cB + hstepB + kstep, voffB);
    PG8_WAIT_V(6); PG8_BAR;
    for (;;) {
        const bool has_next = S.next(ui + 1, nxt);
        const char* nA = uni_ptr(has_next ? (const char*)g.A + (size_t)nxt.pm * tstepA : cA);
        const char* nB = uni_ptr(has_next ? (const char*)g.Bt + (size_t)nxt.pn * tstepB + (size_t)nxt.e * g.estride : cB);
        for (int t = 0; t < nt; t += 2) {
            const bool last = (t == nt - 2);
            const char* a1 = cA + (size_t)(t + 1) * kstep;
            const char* a2 = last ? nA : cA + (size_t)(t + 2) * kstep; const char* b2 = last ? nB : cB + (size_t)(t + 2) * kstep;
            const char* a3 = a2 + kstep; const char* b3 = b2 + kstep;
            PG8_LDB(B0, 0, 0); PG8_LDB(B1, 0, 1); PG8_SCHED; PG8_LDA(At, 0, 0); PG8_STAGE(PG8_SA(1, 1), a1 + hstepA, voffA);
            PG8_WAIT_V(8); PG8_WAIT_L(0); PG8_BAR; PG8_MMA(0, 0, At, B0); PG8_MMA(0, 1, At, B1); PG8_BAR; PG8_SCHED;
            PG8_LDA(At, 0, 1); PG8_STAGE(PG8_SB(0, 0), b2, voffB); PG8_STAGE(PG8_SB(0, 1), b2 + hstepB, voffB); PG8_STAGE(PG8_SA(0, 0), a2, voffA);
            PG8_WAIT_V(8); PG8_WAIT_L(0); PG8_BAR; PG8_MMA(1, 0, At, B0); PG8_MMA(1, 1, At, B1); PG8_BAR; PG8_SCHED;
            PG8_LDB(B0, 1, 0); PG8_LDB(B1, 1, 1); PG8_SCHED; PG8_LDA(At, 1, 0); PG8_STAGE(PG8_SA(0, 1), a2 + hstepA, voffA);
            PG8_WAIT_V(8); PG8_WAIT_L(0); PG8_BAR; PG8_MMA(0, 0, At, B0); PG8_MMA(0, 1, At, B1); PG8_BAR; PG8_SCHED;
            PG8_LDA(At, 1, 1); PG8_STAGE(PG8_SB(1, 0), b3, voffB); PG8_STAGE(PG8_SB(1, 1), b3 + hstepB, voffB); PG8_STAGE(PG8_SA(1, 0), a3, voffA);
            PG8_WAIT_V(8); PG8_WAIT_L(0); PG8_BAR; PG8_MMA(1, 0, At, B0); PG8_MMA(1, 1, At, B1); PG8_BAR; PG8_SCHED;
        }
        if (wr == 0) PG8_BAR;
        if constexpr (I8) {
            const float* qwp = g.qw + (size_t)cur.e * g.qwstride + cur.pn * BM + wc * 32 + (Epi::PERM ? 8 * fq : 4 * fq);
            f32x4 sw_[2][2];
#pragma unroll
            for (int b = 0; b < 2; ++b)
#pragma unroll
                for (int n = 0; n < 2; ++n) sw_[b][n] = *(const f32x4*)(qwp + b * HALF + (Epi::PERM ? 4 : 16) * n);
            const float* qap = g.qa + cur.pm * BM + wr * 64 + fr;
#pragma unroll
            for (int a = 0; a < 2; ++a)
#pragma unroll
                for (int m = 0; m < 4; ++m) { const float sr = qap[a * HALF + m * 16];
#pragma unroll
                    for (int b = 0; b < 2; ++b)
#pragma unroll
                        for (int n = 0; n < 2; ++n) { const i32x4v iv = __builtin_bit_cast(i32x4v, acc[a][b][m][n]);
                            const f32x4 sc = sw_[b][n] * sr; acc[a][b][m][n] = (f32x4){(float)iv[0] * sc[0], (float)iv[1] * sc[1], (float)iv[2] * sc[2], (float)iv[3] * sc[3]}; } }
            __builtin_amdgcn_sched_barrier(0);
        }
        E(acc, cur, wr, wc, fr, fq);
        if (!has_next) break;
#pragma unroll
        for (int a = 0; a < 2; ++a)
#pragma unroll
            for (int b = 0; b < 2; ++b)
#pragma unroll
                for (int m = 0; m < 4; ++m)
#pragma unroll
                    for (int n = 0; n < 2; ++n) acc[a][b][m][n] = (f32x4){0.f, 0.f, 0.f, 0.f};
        cur = nxt; cA = nA; cB = nB; ++ui;
        if (wr == 1) PG8_BAR;
    }
    PG8_WAIT_V(0);
    PG8_BAR;
#undef PG8_SA
#undef PG8_SB
#undef PG8_STAGE
#undef PG8_LDA
#undef PG8_LDB
#undef PG8_MMA
#undef PG8_FR
#undef PG8_WAIT_V
#undef PG8_WAIT_L
#undef PG8_BAR
#undef PG8_SCHED
}
}

namespace att {
constexpr int KSLOT = 12288, VSLOT = 8192;
constexpr int NSL = 4;
constexpr int L_K = 0, L_V = NSL * KSLOT, L_WS = L_V + NSL * VSLOT, L_OST = L_WS + 2048, L_BIAS = L_OST + 32768, L_END = L_BIAS + 4096;
typedef LAS const char* lds_cptr;
__device__ __forceinline__ int crow(int r, int hi) { return (r & 3) + 8 * (r >> 2) + 4 * hi; }
__device__ __forceinline__ void glds16(const void* gsrc, unsigned lds_dst) { unsigned keep;
    asm volatile("s_mov_b32 %0, m0\n\ts_mov_b32 m0, %2\n\ts_nop 0\n\tglobal_load_lds_dwordx4 %1, off\n\ts_mov_b32 m0, %0" : "=&s"(keep) : "v"(gsrc), "s"(lds_dst) : "memory"); }
typedef __bf16 bf16x2_t __attribute__((ext_vector_type(2)));
__device__ __forceinline__ unsigned cvtpk_s(float lo, float hi) { f32x2 v = {lo, hi}; bf16x2_t b = __builtin_convertvector(v, bf16x2_t); return __builtin_bit_cast(unsigned, b); }
#define ATT_WAIT_BAR() asm volatile("s_waitcnt vmcnt(0) lgkmcnt(0)\n\ts_barrier" ::: "memory")
__device__ __forceinline__ v4i16_t vtr(lds_cptr p) { return __builtin_amdgcn_ds_read_tr16_b64_v4i16((LAS v4i16_t*)p); }

struct NoMask {
    __device__ __forceinline__ long tile_row(int t) const { return (long)t * 64; }
    __device__ __forceinline__ bool active(int) const { return true; }
    __device__ __forceinline__ void apply(f32x16&, f32x16&, int, int) const {}
};
struct NaMask {
    long ctx_row0, seq_row0; int kr0, r, rs, j, cs; const LAS float* bias;
    __device__ __forceinline__ long tile_row(int t) const { return t < 4 ? ctx_row0 + 64 * t : seq_row0 + (long)(kr0 + t - 4) * 64; }
    __device__ __forceinline__ bool active(int t) const { const int kr = kr0 + t - 4; return t < 4 || (kr >= rs && kr < rs + 8); }
    __device__ __forceinline__ void apply(f32x16& p0, f32x16& p1, int t, int hi) const {
        if (t < 4) return;
        const int kr = kr0 + t - 4; const LAS float* bp = bias + ((kr - r + 7) * 31 + 15 - j + 4 * hi);
        const unsigned c0 = (unsigned)(4 * hi - cs);
#pragma unroll
        for (int q = 0; q < 16; ++q) { const int kq = (q & 3) + 8 * (q >> 2);
            const bool v0 = (c0 + (unsigned)kq) < 16u, v1 = (c0 + (unsigned)(kq + 32)) < 16u;
            const float b0 = bp[kq], b1 = bp[kq + 32];
            p0[q] = v0 ? p0[q] + b0 : -INFINITY; p1[q] = v1 ? p1[q] + b1 : -INFINITY; }
    }
};

template <int DK, class MK>
__device__ __forceinline__ void attn_unit(const bf16* Qw, int qpitch, const bf16* Kb, int kpitch, const bf16* Vb, int vpitch, bf16* Ow, int opitch, int NT, const MK& mk, LAS unsigned char* shm, const int wid) {
    constexpr int ND = DK / 16, NCH = DK / 8;
    const int lane = lane_id(), r32 = lane & 31, hi = lane >> 5;
    const unsigned lds0 = (unsigned)(uintptr_t)shm;
    const lds_cptr shm3 = (lds_cptr)shm;
    LAS float* wsf = (LAS float*)(shm + L_WS) + wid * 64;
    const bf16* ksrc = Kb + (long)lane * kpitch + wid * 8;
    const bf16* vsrc = Vb + (long)(16 * (wid & 3) + (lane >> 2)) * vpitch + (wid >> 2) * 32 + (lane & 3) * 8;
#define ATT_DMA(t, slot) do { const long r0_ = mk.tile_row(t); \
        glds16(ksrc + r0_ * kpitch, (unsigned)(lds0 + L_K + (slot) * KSLOT + wid * 1024)); \
        if (NCH > 8) { if (wid < NCH - 8) glds16(ksrc + r0_ * kpitch + 64, (unsigned)(lds0 + L_K + (slot) * KSLOT + (wid + 8) * 1024)); } \
        glds16(vsrc + r0_ * vpitch, (unsigned)(lds0 + L_V + (slot) * VSLOT + wid * 1024)); } while (0)
    ATT_DMA(0, 0);
    bf16x8 qr[ND];
#pragma unroll
    for (int d0 = 0; d0 < ND; ++d0) qr[d0] = *(const bf16x8*)(Qw + (long)r32 * qpitch + d0 * 16 + hi * 8);
    float mhat = -1e30f, l_reg = 0.f; f32x16 o[2]; o[0] = f32x16{}; o[1] = f32x16{};
    const int kfo = hi * 1024 + r32 * 16;
    const int vfo = ((lane >> 4) & 1) * 32 + (lane & 3) * 8 + (4 * hi + ((lane & 15) >> 2)) * 64;
    constexpr int DPT = (NCH > 8) ? 3 : 2;
    if (NT > 1) ATT_DMA(1, 1); if (NT > 2) ATT_DMA(2, 2);
    for (int t = 0; t < NT; ++t) {
        if (t + 2 < NT) { if (DPT == 3 && wid < NCH - 8) asm volatile("s_waitcnt vmcnt(6) lgkmcnt(0)\n\ts_barrier" ::: "memory"); else asm volatile("s_waitcnt vmcnt(4) lgkmcnt(0)\n\ts_barrier" ::: "memory"); }
        else if (t + 1 < NT) { if (DPT == 3 && wid < NCH - 8) asm volatile("s_waitcnt vmcnt(3) lgkmcnt(0)\n\ts_barrier" ::: "memory"); else asm volatile("s_waitcnt vmcnt(2) lgkmcnt(0)\n\ts_barrier" ::: "memory"); }
        else ATT_WAIT_BAR();
        if (t + 3 < NT) ATT_DMA(t + 3, (t + 3) & 3);
        if (mk.active(t)) {
            const lds_cptr kp = shm3 + L_K + (t & 3) * KSLOT + kfo;
            f32x16 p0 = f32x16{}, p1 = f32x16{};
#pragma unroll
            for (int d0 = 0; d0 < ND; ++d0) {
                const bf16x8 b0 = *(const LAS bf16x8*)(kp + d0 * 2048), b1 = *(const LAS bf16x8*)(kp + d0 * 2048 + 512);
                p0 = __builtin_amdgcn_mfma_f32_32x32x16_bf16(b0, qr[d0], p0, 0, 0, 0);
                p1 = __builtin_amdgcn_mfma_f32_32x32x16_bf16(b1, qr[d0], p1, 0, 0, 0); }
            mk.apply(p0, p1, t, hi);
            asm volatile("s_nop 7\n\ts_nop 7" : "+v"(p0), "+v"(p1));
            float rm;
            { float ma, mb; asm("v_max3_f32 %0, %1, %2, %3" : "=v"(ma) : "v"(p0[0]), "v"(p0[1]), "v"(p1[0])); asm("v_max3_f32 %0, %1, %2, %3" : "=v"(mb) : "v"(p1[1]), "v"(p0[2]), "v"(p1[2]));
#pragma unroll
              for (int r = 3; r < 15; r += 2) { asm("v_max3_f32 %0, %1, %2, %3" : "=v"(ma) : "v"(ma), "v"(p0[r]), "v"(p1[r])); asm("v_max3_f32 %0, %1, %2, %3" : "=v"(mb) : "v"(mb), "v"(p0[r + 1]), "v"(p1[r + 1])); }
              asm("v_max3_f32 %0, %1, %2, %3" : "=v"(ma) : "v"(ma), "v"(p0[15]), "v"(p1[15])); asm("v_max_f32_e32 %0, %1, %2" : "=v"(rm) : "v"(ma), "v"(mb)); }
            { auto rr = __builtin_amdgcn_permlane32_swap(__float_as_uint(rm), __float_as_uint(rm), false, false); rm = __builtin_fmaxf(__uint_as_float(rr[0]), __uint_as_float(rr[1])); }
            if (__any(rm > mhat + 8.0f)) {
                const float mn = __builtin_fmaxf(mhat, rm); const float f = __builtin_amdgcn_exp2f(mhat - mn); l_reg *= f; mhat = mn;
                if (hi == 0) wsf[r32] = f;
                LDS_WAIT();
#pragma unroll
                for (int d = 0; d < 2; ++d)
#pragma unroll
                    for (int r = 0; r < 16; ++r) o[d][r] *= wsf[crow(r, hi)];
            }
            float sacc = 0.f;
#pragma unroll
            for (int r = 0; r < 16; ++r) { p0[r] = __builtin_amdgcn_exp2f(p0[r] - mhat); p1[r] = __builtin_amdgcn_exp2f(p1[r] - mhat); sacc += p0[r] + p1[r]; }
            l_reg += sacc;
            u32x4 pw0, pw1, pw2, pw3;
            pw0 = (u32x4){cvtpk_s(p0[0], p0[1]), cvtpk_s(p0[2], p0[3]), cvtpk_s(p0[4], p0[5]), cvtpk_s(p0[6], p0[7])};
            pw1 = (u32x4){cvtpk_s(p0[8], p0[9]), cvtpk_s(p0[10], p0[11]), cvtpk_s(p0[12], p0[13]), cvtpk_s(p0[14], p0[15])};
            pw2 = (u32x4){cvtpk_s(p1[0], p1[1]), cvtpk_s(p1[2], p1[3]), cvtpk_s(p1[4], p1[5]), cvtpk_s(p1[6], p1[7])};
            pw3 = (u32x4){cvtpk_s(p1[8], p1[9]), cvtpk_s(p1[10], p1[11]), cvtpk_s(p1[12], p1[13]), cvtpk_s(p1[14], p1[15])};
            const bf16x8 pa[4] = {__builtin_bit_cast(bf16x8, pw0), __builtin_bit_cast(bf16x8, pw1), __builtin_bit_cast(bf16x8, pw2), __builtin_bit_cast(bf16x8, pw3)};
            const lds_cptr vp = shm3 + L_V + (t & 3) * VSLOT + vfo;
#pragma unroll
            for (int d0 = 0; d0 < 2; ++d0)
#pragma unroll
                for (int ks = 0; ks < 4; ++ks) {
                    const v4i16_t lo = vtr(vp + d0 * 4096 + ks * 1024), hh = vtr(vp + d0 * 4096 + ks * 1024 + 512);
                    const bf16x8 vf = (bf16x8){lo[0], lo[1], lo[2], lo[3], hh[0], hh[1], hh[2], hh[3]};
                    o[d0] = __builtin_amdgcn_mfma_f32_32x32x16_bf16(pa[ks], vf, o[d0], 0, 0, 0); }
        }
    }
#undef ATT_DMA
    { auto rr = __builtin_amdgcn_permlane32_swap(__float_as_uint(l_reg), __float_as_uint(l_reg), false, false); l_reg = __uint_as_float(rr[0]) + __uint_as_float(rr[1]); }
    if (hi == 0) wsf[32 + r32] = l_reg;
    LDS_WAIT();
    float rli[16];
#pragma unroll
    for (int r = 0; r < 16; ++r) rli[r] = 1.0f / wsf[32 + crow(r, hi)];
    { LAS bf16* stg = (LAS bf16*)(shm + L_OST) + wid * 2048;
#pragma unroll
        for (int r = 0; r < 16; ++r) { const int orow = crow(r, hi);
#pragma unroll
            for (int d0 = 0; d0 < 2; ++d0) stg[orow * 64 + d0 * 32 + r32] = (bf16)f2bf(o[d0][r] * rli[r]); }
        LDS_WAIT();
#pragma unroll
        for (int i = 0; i < 4; ++i) { const int row = i * 8 + (lane >> 3), ch = lane & 7; const u32x4 v = *(const LAS u32x4*)(stg + row * 64 + ch * 8); *(u32x4*)(Ow + (long)row * opitch + ch * 8) = v; } }
    asm volatile("s_waitcnt lgkmcnt(0)\n\ts_barrier" ::: "memory");
}
}


namespace att64q8 {
typedef int i32x8 __attribute__((ext_vector_type(8)));
#define M8(a,b,c) __builtin_amdgcn_mfma_scale_f32_32x32x64_f8f6f4((a),(b),(c),0,0,0,0x7f7f7f7f,0,0x7c7c7c7c)
#define MPV(a,b,c) __builtin_amdgcn_mfma_scale_f32_32x32x64_f8f6f4((a),(b),(c),1,0,0,0x7f7f7f7f,0,0x7f7f7f7f)
constexpr int NW=8,QBLK=32,QB=QBLK*NW,KVBLK=64;
__device__ __forceinline__ int crow(int r,int hi){return (r&3)+8*(r>>2)+4*hi;}
#define SBAR() __builtin_amdgcn_sched_barrier(0)

constexpr int NSLOT=3, SLOTB=8192;
constexpr int LDS_K=0, LDS_V=NSLOT*SLOTB, LDS_WS=2*NSLOT*SLOTB, LDS_OST=LDS_WS+NW*64*4, LDS_BYTES=LDS_OST+NW*4096;
constexpr float C2=0.125f*1.4426950408889634f;
__device__ __forceinline__ void glds16(const void*gsrc,unsigned lds_dst){unsigned keep;
  asm volatile("s_mov_b32 %0, m0\n\ts_mov_b32 m0, %2\n\ts_nop 0\n\tglobal_load_lds_dwordx4 %1, off\n\ts_mov_b32 m0, %0":"=&s"(keep):"v"(gsrc),"s"(lds_dst):"memory");}
__device__ __forceinline__ void glds16s(const unsigned char*sbase,unsigned voff,unsigned lds_dst){unsigned keep;
  asm volatile("s_mov_b32 %0, m0\n\ts_mov_b32 m0, %3\n\ts_nop 0\n\tglobal_load_lds_dwordx4 %1, %2\n\ts_mov_b32 m0, %0":"=&s"(keep):"v"(voff),"s"(sbase),"s"(lds_dst):"memory");}
__device__ __forceinline__ void glds16h(const unsigned char*sbase,unsigned voff,unsigned lds_dst,unsigned long em){unsigned keep;unsigned long sav;
  asm volatile("s_mov_b32 %0, m0\n\ts_mov_b32 m0, %4\n\ts_mov_b64 %1, exec\n\ts_mov_b64 exec, %5\n\ts_nop 0\n\tglobal_load_lds_dwordx4 %2, %3\n\ts_mov_b64 exec, %1\n\ts_mov_b32 m0, %0":"=&s"(keep),"=&s"(sav):"v"(voff),"s"(sbase),"s"(lds_dst),"s"(em):"memory");}
__device__ __forceinline__ const unsigned char* uptr(const unsigned char*p){ const unsigned lo=__builtin_amdgcn_readfirstlane((unsigned)(uintptr_t)p),hi=__builtin_amdgcn_readfirstlane((unsigned)((uintptr_t)p>>32)); return (const unsigned char*)(((uintptr_t)hi<<32)|lo); }
__device__ __forceinline__ float max3f(float a,float b,float c){float r;asm("v_max3_f32 %0, %1, %2, %3":"=v"(r):"v"(a),"v"(b),"v"(c));return r;}
__device__ __forceinline__ float max2f(float a,float b){float r;asm("v_max_f32_e32 %0, %1, %2":"=v"(r):"v"(a),"v"(b));return r;}
__device__ __forceinline__ float fadd_s(float a,float b){float r;asm("v_add_f32_e32 %0, %1, %2":"=v"(r):"v"(a),"v"(b));return r;}
__device__ __forceinline__ float fsub_s(float a,float b){float r;asm("v_sub_f32_e32 %0, %1, %2":"=v"(r):"v"(a),"v"(b));return r;}
typedef float f32x2_t __attribute__((ext_vector_type(2))); typedef __bf16 bf16x2_t __attribute__((ext_vector_type(2))); typedef short s16x4 __attribute__((ext_vector_type(4)));
__device__ __forceinline__ unsigned cvtpk_s(float lo,float hi){f32x2_t v={lo,hi};bf16x2_t b=__builtin_convertvector(v,bf16x2_t);return __builtin_bit_cast(unsigned,b);}
#define WAIT_BAR(N) asm volatile("s_waitcnt vmcnt(" #N ") lgkmcnt(0)\n\ts_barrier":::"memory")

__device__ __forceinline__ void qkt(f32x16&p0,f32x16&p1,const char*Kslot,const i32x8&q8,const f32x16&negm,int r32,int hi){
  const int sw=(r32>>2)&3; const char*k0=Kslot+r32*64; const int c0=((2*hi)^sw)<<4, c1=((2*hi+1)^sw)<<4;
  const u32x4 a0=*reinterpret_cast<const u32x4*>(k0+c0), a1=*reinterpret_cast<const u32x4*>(k0+c1), b0=*reinterpret_cast<const u32x4*>(k0+2048+c0), b1=*reinterpret_cast<const u32x4*>(k0+2048+c1);
  const i32x8 ka={(int)a0.x,(int)a0.y,(int)a0.z,(int)a0.w,(int)a1.x,(int)a1.y,(int)a1.z,(int)a1.w}, kb={(int)b0.x,(int)b0.y,(int)b0.z,(int)b0.w,(int)b1.x,(int)b1.y,(int)b1.z,(int)b1.w};
  p0=M8(ka,q8,negm); p1=M8(kb,q8,negm);
}
typedef __attribute__((address_space(3))) const char* lds_cptr;
typedef short v4i16_t __attribute__((ext_vector_type(4)));
__device__ __forceinline__ i32x8 kfr(lds_cptr p0,lds_cptr p1){ const u32x4 a=*(const __attribute__((address_space(3))) u32x4*)p0, b=*(const __attribute__((address_space(3))) u32x4*)p1;
  return (i32x8){(int)a.x,(int)a.y,(int)a.z,(int)a.w,(int)b.x,(int)b.y,(int)b.z,(int)b.w}; }
__device__ __forceinline__ s16x4 vtr(lds_cptr p){ return __builtin_bit_cast(s16x4,__builtin_amdgcn_ds_read_tr16_b64_v4i16((__attribute__((address_space(3))) v4i16_t*)p)); }
__device__ __forceinline__ float rowmax(const f32x16&p0,const f32x16&p1){
  float a=max3f(p0[0],p0[1],p1[0]),b=max3f(p0[2],p0[3],p1[1]);a=max3f(a,p1[2],p1[3]);
  #pragma unroll
  for(int r=4;r<16;r+=4){a=max3f(a,p0[r],p0[r+1]);b=max3f(b,p0[r+2],p0[r+3]);a=max3f(a,p1[r],p1[r+1]);b=max3f(b,p1[r+2],p1[r+3]);}
  const float m=max2f(a,b);
  auto rr=__builtin_amdgcn_permlane32_swap(__float_as_uint(m),__float_as_uint(m),false,false);
  return max2f(__uint_as_float(rr[0]),__uint_as_float(rr[1]));
}
__device__ __forceinline__ void pv(f32x16*o,int vb,bf16x8 pa0,bf16x8 pa1,bf16x8 pa2,bf16x8 pa3){
  #pragma unroll
  for(int d0=0;d0<2;++d0){s16x4 lo[4],hi[4];
    #pragma unroll
    for(int ks=0;ks<4;++ks){
      asm volatile("ds_read_b64_tr_b16 %0,%1 offset:%c2":"=&v"(lo[ks]):"v"(vb),"i"(d0*4096+ks*1024):"memory");
      asm volatile("ds_read_b64_tr_b16 %0,%1 offset:%c2":"=&v"(hi[ks]):"v"(vb),"i"(d0*4096+ks*1024+512):"memory");}
    asm volatile("s_waitcnt lgkmcnt(0)":::"memory");SBAR();
    #define PK(k) (bf16x8){lo[k][0],lo[k][1],lo[k][2],lo[k][3],hi[k][0],hi[k][1],hi[k][2],hi[k][3]}
    o[d0]=__builtin_amdgcn_mfma_f32_32x32x16_bf16(pa0,PK(0),o[d0],0,0,0);
    o[d0]=__builtin_amdgcn_mfma_f32_32x32x16_bf16(pa1,PK(1),o[d0],0,0,0);
    o[d0]=__builtin_amdgcn_mfma_f32_32x32x16_bf16(pa2,PK(2),o[d0],0,0,0);
    o[d0]=__builtin_amdgcn_mfma_f32_32x32x16_bf16(pa3,PK(3),o[d0],0,0,0);
    #undef PK
  }
}

#ifndef ATTN_STORE16
#define ATTN_STORE16(p,v) (*(u32x4*)(p)=(v))
#endif

template<int THRL,int QP,int KP,int VP,int OP,int FIX=0> __device__ __forceinline__ bool attn_unit(const unsigned char*Qu,const unsigned char*__restrict__ Kh,const unsigned char*__restrict__ Vh,bf16*Ou,const int NT,char*shm,const int wid,const float refB=0.f){
  const int lane=lane_id(),r32=lane&31,hi=lane>>5;
  const unsigned char*Qw=Qu+(long)wid*QBLK*QP;
  const unsigned lds0=(unsigned)(uintptr_t)shm;
  float*wsf=(float*)(shm+LDS_WS)+wid*64;
  const int kkey=(wid&3)*16+(lane>>2);
  const unsigned kvo=(unsigned)(kkey*KP+(((lane&3)^((kkey>>2)&3))<<4)); const unsigned char*Kb_=uptr(Kh);
  const unsigned vvo=(unsigned)((wid&3)*1024+lane*16); const unsigned char*Vb_=uptr((const unsigned char*)Vh);
  const unsigned kdst=lds0+LDS_K+(wid&3)*1024, vdst=lds0+LDS_V+(wid&3)*1024;
  const unsigned long hm_=(wid>>2)?0xFFFFFFFF00000000ul:0x00000000FFFFFFFFul;
  #define DMA_K(t,slot) glds16h(Kb_+(long)(t)*KVBLK*KP,kvo,(unsigned)(kdst+(slot)),hm_)
  #define DMA_V(t,slot) glds16h(Vb_+(long)(t)*4096,vvo,(unsigned)(vdst+(slot)),hm_)
  const char*Kbase=shm+LDS_K; i32x8 kf8[2];
  const lds_cptr shm3=(lds_cptr)shm; const lds_cptr kpc0=shm3+LDS_K+r32*64+((((2*hi)^((r32>>2)&3)))<<4), kpc1=shm3+LDS_K+r32*64+((((2*hi+1)^((r32>>2)&3)))<<4);
  DMA_K(0,0);DMA_V(0,0);DMA_K(1,SLOTB);
  const i32x8 q8=*reinterpret_cast<const i32x8*>(Qw+(long)r32*QP+hi*32);
  constexpr float POFF = FIX ? 15.0f : 7.0f;
  float mhat=0.f;f32x16 o[2];o[0]=f32x16{};o[1]=f32x16{};f32x16 ls=f32x16{};f32x16 negm=f32x16{};
  { _Pragma("unroll") for(int r=0;r<16;++r)negm[r]=FIX?(POFF-refB):POFF; } asm volatile("":"+v"(negm));
  i32x8 ones8={0x38383838,0x38383838,0x38383838,0x38383838,0x38383838,0x38383838,0x38383838,0x38383838}; asm volatile("":"+v"(ones8));
  const lds_cptr vpc0=shm3+LDS_V+r32*64+((((2*hi)^((r32>>2)&3)))<<4), vpc1=shm3+LDS_V+r32*64+((((2*hi+1)^((r32>>2)&3)))<<4);
  #define CMASK(P0,P1,t) do{}while(0)
  bool resc=false;
  #define START(P0,P1) do{ if constexpr(!FIX){ const float rm=rowmax(P0,P1)-POFF; resc=false; \
    { const float dl=rm; mhat=fadd_s(mhat,dl); \
      _Pragma("unroll") for(int r=0;r<16;++r){P0[r]=fsub_s(P0[r],dl);P1[r]=fsub_s(P1[r],dl);} \
      _Pragma("unroll") for(int r=0;r<16;++r)negm[r]=POFF-mhat; asm volatile("":"+v"(negm)); } } \
    _Pragma("unroll") for(int r=0;r<16;++r)P0[r]=__builtin_amdgcn_exp2f(P0[r]); }while(0)
  #define RESC() do{ if constexpr(!FIX) if(resc){ asm volatile("s_waitcnt lgkmcnt(0)":::"memory"); \
      _Pragma("unroll") for(int r=0;r<16;++r){ const float f_=wsf[crow(r,hi)]; o[0][r]*=f_; o[1][r]*=f_; ls[r]*=f_; } } }while(0)
  f32x16 pA0,pA1,pB0,pB1;
  int sl_prev=0,sl_cur=0,sl_next=SLOTB;
  #define ROT() do{sl_prev=sl_cur;sl_cur=sl_next;sl_next=(sl_next==(NSLOT-1)*SLOTB)?0:sl_next+SLOTB;}while(0)
  DMA_K(2,2*SLOTB);
  WAIT_BAR(3);
  qkt(pA0,pA1,Kbase,q8,negm,r32,hi);asm volatile("s_nop 15\n\ts_nop 7":"+v"(pA0),"+v"(pA1));CMASK(pA0,pA1,0);
  START(pA0,pA1);
  _Pragma("unroll") for(int r=0;r<16;++r)pA1[r]=__builtin_amdgcn_exp2f(pA1[r]);
  WAIT_BAR(0);
  DMA_K(3,0);DMA_V(1,SLOTB);
  ROT();
  kf8[0]=kfr(kpc0+sl_cur,kpc1+sl_cur); kf8[1]=kfr(kpc0+sl_cur+2048,kpc1+sl_cur+2048);
  WAIT_BAR(2);
  i32x8 pb=i32x8{}, vf0, vf1;
  #define PIN(x) asm volatile("":"+v"(x))
  #define MX3(a,b,c) __builtin_fmaxf(__builtin_fmaxf((a),(b)),(c))
  #define EX(v) __builtin_amdgcn_exp2f(v)
  #define PK8(P,B,OLD,HI) __builtin_amdgcn_cvt_pk_bf8_f32(P[B],P[(B)+1],OLD,HI)
  #define CV8(P,D0) do{ int x0_=pb[(D0)],x1_=pb[(D0)+1],x2_=pb[(D0)+2],x3_=pb[(D0)+3];        \
      x0_=PK8(P,0,x0_,false); x0_=PK8(P,2,x0_,true); x1_=PK8(P,4,x1_,false); x1_=PK8(P,6,x1_,true); \
      x2_=PK8(P,8,x2_,false); x2_=PK8(P,10,x2_,true); x3_=PK8(P,12,x3_,false); x3_=PK8(P,14,x3_,true); \
      pb[(D0)]=x0_; pb[(D0)+1]=x1_; pb[(D0)+2]=x2_; pb[(D0)+3]=x3_; }while(0)
  #define EX8(X,B) do{ X[(B)]=EX(X[(B)]); X[(B)+1]=EX(X[(B)+1]); X[(B)+2]=EX(X[(B)+2]); X[(B)+3]=EX(X[(B)+3]); X[(B)+4]=EX(X[(B)+4]); X[(B)+5]=EX(X[(B)+5]); X[(B)+6]=EX(X[(B)+6]); X[(B)+7]=EX(X[(B)+7]); PIN(X); }while(0)
  #define KRD(G,j,SN) do{ if(G){ kf8[j]=kfr(kpc0+(SN)+(j)*2048,kpc1+(SN)+(j)*2048); SBAR(); } }while(0)
  #define STEP(C0,C1,P0,P1,t,GK,GV,GL,SP,SC,SN) do{ SBAR(); \
    vf0=kfr(vpc0+(SP),vpc1+(SP)); vf1=kfr(vpc0+(SP)+2048,vpc1+(SP)+2048); SBAR(); \
    C0=M8(kf8[0],q8,negm); SBAR(); CV8(P0,0); PIN(pb); SBAR();        \
    C1=M8(kf8[1],q8,negm); SBAR(); CV8(P1,4); PIN(pb); SBAR(); \
    if(GK){DMA_K((t)+3,(SC));} if(GV){DMA_V((t)+1,(SN));} \
    CMASK(C0,C1,t); \
    if constexpr(!FIX){ float a=MX3(C0[0],C0[1],C1[0]),b=MX3(C0[2],C0[3],C1[1]); a=MX3(a,C1[2],C1[3]); \
      _Pragma("unroll") for(int r=4;r<16;r+=4){a=MX3(a,C0[r],C0[r+1]);b=MX3(b,C0[r+2],C0[r+3]);a=MX3(a,C1[r],C1[r+1]);b=MX3(b,C1[r+2],C1[r+3]);} \
      float rm=__builtin_fmaxf(a,b); { auto rr=__builtin_amdgcn_permlane32_swap(__float_as_uint(rm),__float_as_uint(rm),false,false); rm=__builtin_fmaxf(__uint_as_float(rr[0]),__uint_as_float(rr[1])); } \
      rm-=POFF; resc=false; \
      if(__builtin_expect(__any(rm>(float)THRL),0)){ const float dl=__builtin_fmaxf(rm,0.f); mhat+=dl; \
        _Pragma("unroll") for(int r=0;r<16;++r){C0[r]-=dl;C1[r]-=dl;} \
        _Pragma("unroll") for(int r=0;r<16;++r)negm[r]=POFF-mhat; asm volatile("":"+v"(negm)); \
        const float f=__builtin_amdgcn_exp2f(-dl); if(hi==0)wsf[r32]=f; resc=true; } } \
    SBAR(); \
    o[0]=MPV(pb,vf0,o[0]); EX8(C0,0); SBAR(); \
    KRD(GL,0,SN); o[1]=MPV(pb,vf1,o[1]); EX8(C0,8); SBAR(); \
    KRD(GL,1,SN); ls=MPV(pb,ones8,ls); EX8(C1,0); SBAR(); \
    EX8(C1,8); SBAR(); \
    }while(0)
  if(wid>=4)__builtin_amdgcn_s_setprio(1);
  int t=1;
  for(;t+9<NT;t+=6){
    STEP(pB0,pB1,pA0,pA1,t,  true,true,true,0,SLOTB,2*SLOTB);       WAIT_BAR(2); RESC();
    STEP(pA0,pA1,pB0,pB1,t+1,true,true,true,SLOTB,2*SLOTB,0);       WAIT_BAR(2); RESC();
    STEP(pB0,pB1,pA0,pA1,t+2,true,true,true,2*SLOTB,0,SLOTB);       WAIT_BAR(2); RESC();
    STEP(pA0,pA1,pB0,pB1,t+3,true,true,true,0,SLOTB,2*SLOTB);       WAIT_BAR(2); RESC();
    STEP(pB0,pB1,pA0,pA1,t+4,true,true,true,SLOTB,2*SLOTB,0);       WAIT_BAR(2); RESC();
    STEP(pA0,pA1,pB0,pB1,t+5,true,true,true,2*SLOTB,0,SLOTB);       WAIT_BAR(2); RESC();
  }
  #define ENDW(tt) do{ if((tt)+3<NT){WAIT_BAR(2);} else if((tt)+2<NT){WAIT_BAR(1);} else {WAIT_BAR(0);} }while(0)
  for(;t+1<NT;t+=2){
    STEP(pB0,pB1,pA0,pA1,t,(t+3<NT),(t+1<NT),(t+1<NT),sl_prev,sl_cur,sl_next);       ENDW(t);   RESC(); ROT();
    STEP(pA0,pA1,pB0,pB1,t+1,(t+4<NT),(t+2<NT),(t+2<NT),sl_prev,sl_cur,sl_next);     ENDW(t+1); RESC(); ROT();
  }
  STEP(pB0,pB1,pA0,pA1,NT-1,false,false,false,sl_prev,sl_cur,sl_next); RESC();
  { CV8(pB0,0); CV8(pB1,4); PIN(pb); SBAR();
    vf0=kfr(vpc0+sl_cur,vpc1+sl_cur); vf1=kfr(vpc0+sl_cur+2048,vpc1+sl_cur+2048);
    o[0]=MPV(pb,vf0,o[0]); o[1]=MPV(pb,vf1,o[1]); ls=MPV(pb,ones8,ls); }
  #undef PIN
  #undef MX3
  #undef EX
  #undef PK8
  #undef CV8
  #undef EX8
  #undef KRD
  #undef STEP
  #undef ENDW
  __builtin_amdgcn_s_setprio(0);
  float rli[16]; float lmin=ls[0];
  #pragma unroll
  for(int r=0;r<16;++r){ rli[r]=__builtin_amdgcn_rcpf(ls[r]); lmin=__builtin_fminf(lmin,ls[r]); }
  const bool sunk=FIX&&__any(!(lmin>=1.0f));
  bf16*Ow=Ou+(long)wid*QBLK*OP;
  { bf16*stg=(bf16*)(shm+LDS_OST)+wid*2048;
    #pragma unroll
    for(int r=0;r<16;++r){const int orow=crow(r,hi);
      #pragma unroll
      for(int d0=0;d0<2;++d0)stg[orow*64+d0*32+r32]=(bf16)f2bf(o[d0][r]*rli[r]);}
    asm volatile("s_waitcnt lgkmcnt(0)":::"memory");
    #pragma unroll
    for(int i=0;i<4;++i){const int row=i*8+(lane>>3),ch=lane&7; const u32x4 v=*(const u32x4*)(stg+row*64+ch*8); ATTN_STORE16(Ow+(long)row*OP+ch*8,v);} }
  asm volatile("s_waitcnt lgkmcnt(0)\n\ts_barrier":::"memory");
  #undef DMA_K
  #undef DMA_V
  #undef CMASK
  #undef START
  #undef RESC
  #undef ROT
  return sunk;
}

#undef SBAR
#undef WAIT_BAR
constexpr int ATTN_LDS_BYTES=LDS_BYTES;
#undef M8
}

namespace att96q8 {
typedef int i32x8 __attribute__((ext_vector_type(8)));
#define M8(a,b,c) __builtin_amdgcn_mfma_scale_f32_32x32x64_f8f6f4((a),(b),(c),0,0,0,0x7f7f7f7f,0,0x7c7c7c7c)
#define MPV(a,b,c) __builtin_amdgcn_mfma_scale_f32_32x32x64_f8f6f4((a),(b),(c),1,0,0,0x7f7f7f7f,0,0x7f7f7f7f)
#define MSUM(a,b,c) __builtin_amdgcn_mfma_scale_f32_16x16x128_f8f6f4((a),(b),(c),1,0,0,0,0,0)
constexpr int NW=8,QBLK=32,QB=QBLK*NW,KVBLK=64;
__device__ __forceinline__ int crow(int r,int hi){return (r&3)+8*(r>>2)+4*hi;}
#define SBAR() __builtin_amdgcn_sched_barrier(0)

constexpr int NSLOT=3, SLOTB=8192;
constexpr int LDS_K=0, LDS_V=NSLOT*SLOTB, LDS_WS=2*NSLOT*SLOTB, LDS_OST=LDS_WS+NW*64*4, LDS_BYTES=LDS_OST+NW*4096;
constexpr float C2=0.125f*1.4426950408889634f;
__device__ __forceinline__ void glds16(const void*gsrc,unsigned lds_dst){unsigned keep;
  asm volatile("s_mov_b32 %0, m0\n\ts_mov_b32 m0, %2\n\ts_nop 0\n\tglobal_load_lds_dwordx4 %1, off\n\ts_mov_b32 m0, %0":"=&s"(keep):"v"(gsrc),"s"(lds_dst):"memory");}
__device__ __forceinline__ void glds16s(const unsigned char*sbase,unsigned voff,unsigned lds_dst){unsigned keep;
  asm volatile("s_mov_b32 %0, m0\n\ts_mov_b32 m0, %3\n\ts_nop 0\n\tglobal_load_lds_dwordx4 %1, %2\n\ts_mov_b32 m0, %0":"=&s"(keep):"v"(voff),"s"(sbase),"s"(lds_dst):"memory");}
__device__ __forceinline__ void glds16h(const unsigned char*sbase,unsigned voff,unsigned lds_dst,unsigned long em){unsigned keep;unsigned long sav;
  asm volatile("s_mov_b32 %0, m0\n\ts_mov_b32 m0, %4\n\ts_mov_b64 %1, exec\n\ts_mov_b64 exec, %5\n\ts_nop 0\n\tglobal_load_lds_dwordx4 %2, %3\n\ts_mov_b64 exec, %1\n\ts_mov_b32 m0, %0":"=&s"(keep),"=&s"(sav):"v"(voff),"s"(sbase),"s"(lds_dst),"s"(em):"memory");}
__device__ __forceinline__ const unsigned char* uptr(const unsigned char*p){ const unsigned lo=__builtin_amdgcn_readfirstlane((unsigned)(uintptr_t)p),hi=__builtin_amdgcn_readfirstlane((unsigned)((uintptr_t)p>>32)); return (const unsigned char*)(((uintptr_t)hi<<32)|lo); }
__device__ __forceinline__ float max3f(float a,float b,float c){float r;asm("v_max3_f32 %0, %1, %2, %3":"=v"(r):"v"(a),"v"(b),"v"(c));return r;}
__device__ __forceinline__ float max2f(float a,float b){float r;asm("v_max_f32_e32 %0, %1, %2":"=v"(r):"v"(a),"v"(b));return r;}
__device__ __forceinline__ float fadd_s(float a,float b){float r;asm("v_add_f32_e32 %0, %1, %2":"=v"(r):"v"(a),"v"(b));return r;}
__device__ __forceinline__ float fsub_s(float a,float b){float r;asm("v_sub_f32_e32 %0, %1, %2":"=v"(r):"v"(a),"v"(b));return r;}
typedef float f32x2_t __attribute__((ext_vector_type(2))); typedef __bf16 bf16x2_t __attribute__((ext_vector_type(2))); typedef short s16x4 __attribute__((ext_vector_type(4)));
__device__ __forceinline__ unsigned cvtpk_s(float lo,float hi){f32x2_t v={lo,hi};bf16x2_t b=__builtin_convertvector(v,bf16x2_t);return __builtin_bit_cast(unsigned,b);}
#define WAIT_BAR(N) asm volatile("s_waitcnt vmcnt(" #N ") lgkmcnt(0)\n\ts_barrier":::"memory")

__device__ __forceinline__ void qkt(f32x16&p0,f32x16&p1,const char*Kslot,const i32x8*q8,const f32x16&negm,int r32,int hi){
  const int sw=(r32>>1)&7; const char*k0=Kslot+r32*128;
  #define KF_(kb_,p_) ({ const u32x4 a_=*reinterpret_cast<const u32x4*>(k0+(kb_)*4096+(((4*(p_)+2*hi)^sw)<<4)), b_=*reinterpret_cast<const u32x4*>(k0+(kb_)*4096+(((4*(p_)+2*hi+1)^sw)<<4)); \
      (i32x8){(int)a_.x,(int)a_.y,(int)a_.z,(int)a_.w,(int)b_.x,(int)b_.y,(int)b_.z,(int)b_.w}; })
  p0=M8(KF_(0,0),q8[0],negm); p1=M8(KF_(1,0),q8[0],negm); p0=M8(KF_(0,1),q8[1],p0); p1=M8(KF_(1,1),q8[1],p1);
  #undef KF_
}
typedef __attribute__((address_space(3))) const char* lds_cptr;
typedef short v4i16_t __attribute__((ext_vector_type(4)));
__device__ __forceinline__ i32x8 kfr(lds_cptr p0,lds_cptr p1){ const u32x4 a=*(const __attribute__((address_space(3))) u32x4*)p0, b=*(const __attribute__((address_space(3))) u32x4*)p1;
  return (i32x8){(int)a.x,(int)a.y,(int)a.z,(int)a.w,(int)b.x,(int)b.y,(int)b.z,(int)b.w}; }
__device__ __forceinline__ s16x4 vtr(lds_cptr p){ return __builtin_bit_cast(s16x4,__builtin_amdgcn_ds_read_tr16_b64_v4i16((__attribute__((address_space(3))) v4i16_t*)p)); }
__device__ __forceinline__ float rowmax(const f32x16&p0,const f32x16&p1){
  float a=max3f(p0[0],p0[1],p1[0]),b=max3f(p0[2],p0[3],p1[1]);a=max3f(a,p1[2],p1[3]);
  #pragma unroll
  for(int r=4;r<16;r+=4){a=max3f(a,p0[r],p0[r+1]);b=max3f(b,p0[r+2],p0[r+3]);a=max3f(a,p1[r],p1[r+1]);b=max3f(b,p1[r+2],p1[r+3]);}
  const float m=max2f(a,b);
  auto rr=__builtin_amdgcn_permlane32_swap(__float_as_uint(m),__float_as_uint(m),false,false);
  return max2f(__uint_as_float(rr[0]),__uint_as_float(rr[1]));
}
__device__ __forceinline__ void pv(f32x16*o,int vb,bf16x8 pa0,bf16x8 pa1,bf16x8 pa2,bf16x8 pa3){
  #pragma unroll
  for(int d0=0;d0<2;++d0){s16x4 lo[4],hi[4];
    #pragma unroll
    for(int ks=0;ks<4;++ks){
      asm volatile("ds_read_b64_tr_b16 %0,%1 offset:%c2":"=&v"(lo[ks]):"v"(vb),"i"(d0*4096+ks*1024):"memory");
      asm volatile("ds_read_b64_tr_b16 %0,%1 offset:%c2":"=&v"(hi[ks]):"v"(vb),"i"(d0*4096+ks*1024+512):"memory");}
    asm volatile("s_waitcnt lgkmcnt(0)":::"memory");SBAR();
    #define PK(k) (bf16x8){lo[k][0],lo[k][1],lo[k][2],lo[k][3],hi[k][0],hi[k][1],hi[k][2],hi[k][3]}
    o[d0]=__builtin_amdgcn_mfma_f32_32x32x16_bf16(pa0,PK(0),o[d0],0,0,0);
    o[d0]=__builtin_amdgcn_mfma_f32_32x32x16_bf16(pa1,PK(1),o[d0],0,0,0);
    o[d0]=__builtin_amdgcn_mfma_f32_32x32x16_bf16(pa2,PK(2),o[d0],0,0,0);
    o[d0]=__builtin_amdgcn_mfma_f32_32x32x16_bf16(pa3,PK(3),o[d0],0,0,0);
    #undef PK
  }
}

#ifndef ATTN_STORE16
#define ATTN_STORE16(p,v) (*(u32x4*)(p)=(v))
#endif

template<int THRL,int QP,int KP,int VP,int OP> __device__ __forceinline__ bool attn_unit(const unsigned char*Qu,const unsigned char*__restrict__ Kh,const unsigned char*__restrict__ Vh,bf16*Ou,const int NT,char*shm,const int wid,const float kmax,const bool allow_fix){
  const int lane=lane_id(),r32=lane&31,hi=lane>>5;
  const unsigned char*Qw=Qu+(long)wid*QBLK*QP;
  const unsigned lds0=(unsigned)(uintptr_t)shm;
  float*wsf=(float*)(shm+LDS_WS)+wid*64;
  const int kkey=wid*8+(lane>>3);
  const unsigned kvo=(unsigned)(kkey*KP+(((lane&7)^((kkey>>1)&7))<<4)); const unsigned char*Kb_=uptr(Kh);
  const unsigned vvo=(unsigned)((wid&3)*1024+lane*16); const unsigned char*Vb_=uptr(Vh);
  const unsigned kdst=lds0+LDS_K+wid*1024, vdst=lds0+LDS_V+(wid&3)*1024;
  #define DMA_K(t,slot) glds16s(Kb_+(long)(t)*KVBLK*KP,kvo,(unsigned)(kdst+(slot)))
  const unsigned long hm_=(wid>>2)?0xFFFFFFFF00000000ul:0x00000000FFFFFFFFul;
  #define DMA_V(t,slot) glds16h(Vb_+(long)(t)*4096,vvo,(unsigned)(vdst+(slot)),hm_)
  const char*Kbase=shm+LDS_K; i32x8 kf8[4];
  const lds_cptr shm3=(lds_cptr)shm; const int ksw=(r32>>1)&7; const lds_cptr kq00=shm3+LDS_K+r32*128+(((2*hi)^ksw)<<4), kq01=shm3+LDS_K+r32*128+(((2*hi+1)^ksw)<<4), kq10=shm3+LDS_K+r32*128+(((4+2*hi)^ksw)<<4), kq11=shm3+LDS_K+r32*128+(((5+2*hi)^ksw)<<4);
  #define KFRAG(j_,so_) (((j_)&1) ? kfr(kq10+(so_)+((j_)>>1)*4096,kq11+(so_)+((j_)>>1)*4096) : kfr(kq00+(so_)+((j_)>>1)*4096,kq01+(so_)+((j_)>>1)*4096))
  DMA_K(0,0);DMA_V(0,0);DMA_K(1,SLOTB);
  i32x8 q8[2]; q8[0]=*reinterpret_cast<const i32x8*>(Qw+(long)r32*QP+hi*32); q8[1]=*reinterpret_cast<const i32x8*>(Qw+(long)r32*QP+64+hi*32);
  float mhat=0.f;f32x16 o[2];o[0]=f32x16{};o[1]=f32x16{};f32x4 ls4={0.f,0.f,0.f,0.f};f32x16 negm=f32x16{};
  bool fx=false; float POFF=7.0f;
  { float qn=0.f;
    _Pragma("unroll") for(int p=0;p<2;++p) _Pragma("unroll") for(int e=0;e<8;++e){ const int w_=q8[p][e]; const float a0=__builtin_amdgcn_cvt_f32_fp8(w_,0),a1=__builtin_amdgcn_cvt_f32_fp8(w_,1),a2=__builtin_amdgcn_cvt_f32_fp8(w_,2),a3=__builtin_amdgcn_cvt_f32_fp8(w_,3); qn+=(a0*a0+a1*a1)+(a2*a2+a3*a3); }
    { auto rr=__builtin_amdgcn_permlane32_swap(__float_as_uint(qn),__float_as_uint(qn),false,false); qn=__uint_as_float(rr[0])+__uint_as_float(rr[1]); }
    const float brow=sqrtf(qn)*0.125f*kmax*1.002f+0.05f;
    fx=allow_fix&&(kmax>0.f)&&!__any(!(brow<55.0f));
    POFF=fx?15.0f:7.0f;
    _Pragma("unroll") for(int r=0;r<16;++r)negm[r]=fx?(POFF-brow):POFF; }
  asm volatile("":"+v"(negm));
  const int om_=(((lane>>4)&1)==((lane>>3)&1))?0x38383838:0; i32x8 onesm={om_,om_,om_,om_,om_,om_,om_,om_}; asm volatile("":"+v"(onesm));
  const int lsq=4*(lane>>4)+16*((lane>>3)&1);
  const lds_cptr vpc0=shm3+LDS_V+r32*64+((((2*hi)^((r32>>2)&3)))<<4), vpc1=shm3+LDS_V+r32*64+((((2*hi+1)^((r32>>2)&3)))<<4);
  #define CMASK(P0,P1,t) do{}while(0)
  bool resc=false;
  #define START(P0,P1) do{ if(!fx){ const float rm=rowmax(P0,P1)-POFF; resc=false; \
    { const float dl=rm; mhat=fadd_s(mhat,dl); \
      _Pragma("unroll") for(int r=0;r<16;++r){P0[r]=fsub_s(P0[r],dl);P1[r]=fsub_s(P1[r],dl);} \
      _Pragma("unroll") for(int r=0;r<16;++r)negm[r]=POFF-mhat; asm volatile("":"+v"(negm)); } } \
    _Pragma("unroll") for(int r=0;r<16;++r)P0[r]=__builtin_amdgcn_exp2f(P0[r]); }while(0)
  #define RESC() do{ if(resc){ asm volatile("s_waitcnt lgkmcnt(0)":::"memory"); \
      _Pragma("unroll") for(int r=0;r<16;++r){ const float f_=wsf[crow(r,hi)]; o[0][r]*=f_; o[1][r]*=f_; } \
      _Pragma("unroll") for(int r=0;r<4;++r)ls4[r]*=wsf[lsq+r]; } }while(0)
  f32x16 pA0,pA1,pB0,pB1;
  int sl_prev=0,sl_cur=0,sl_next=SLOTB;
  #define ROT() do{sl_prev=sl_cur;sl_cur=sl_next;sl_next=(sl_next==(NSLOT-1)*SLOTB)?0:sl_next+SLOTB;}while(0)
  DMA_K(2,2*SLOTB);
  WAIT_BAR(3);
  qkt(pA0,pA1,Kbase,q8,negm,r32,hi);asm volatile("s_nop 15\n\ts_nop 7":"+v"(pA0),"+v"(pA1));CMASK(pA0,pA1,0);
  START(pA0,pA1);
  _Pragma("unroll") for(int r=0;r<16;++r)pA1[r]=__builtin_amdgcn_exp2f(pA1[r]);
  WAIT_BAR(0);
  DMA_K(3,0);DMA_V(1,SLOTB);
  ROT();
  kf8[0]=KFRAG(0,sl_cur); kf8[1]=KFRAG(1,sl_cur); kf8[2]=KFRAG(2,sl_cur); kf8[3]=KFRAG(3,sl_cur);
  WAIT_BAR(2);
  i32x8 pb=i32x8{}, vf0, vf1;
  #define PIN(x) asm volatile("":"+v"(x))
  #define MX3(a,b,c) __builtin_fmaxf(__builtin_fmaxf((a),(b)),(c))
  #define EX(v) __builtin_amdgcn_exp2f(v)
  #define PK8(P,B,OLD,HI) __builtin_amdgcn_cvt_pk_bf8_f32(P[B],P[(B)+1],OLD,HI)
  #define CV4(P,PB0,D0) do{ int x0_=pb[(D0)],x1_=pb[(D0)+1];        \
      x0_=PK8(P,(PB0),x0_,false); x0_=PK8(P,(PB0)+2,x0_,true); x1_=PK8(P,(PB0)+4,x1_,false); x1_=PK8(P,(PB0)+6,x1_,true); \
      pb[(D0)]=x0_; pb[(D0)+1]=x1_; }while(0)
  #define EX8(X,B) do{ X[(B)]=EX(X[(B)]); X[(B)+1]=EX(X[(B)+1]); X[(B)+2]=EX(X[(B)+2]); X[(B)+3]=EX(X[(B)+3]); X[(B)+4]=EX(X[(B)+4]); X[(B)+5]=EX(X[(B)+5]); X[(B)+6]=EX(X[(B)+6]); X[(B)+7]=EX(X[(B)+7]); PIN(X); }while(0)
  #define KRD(G,j,SN) do{ if(G){ kf8[j]=KFRAG(j,(SN)); SBAR(); } }while(0)
  #define STEP(C0,C1,P0,P1,t,GK,GV,GL,SP,SC,SN) do{ SBAR(); \
    vf0=kfr(vpc0+(SP),vpc1+(SP)); vf1=kfr(vpc0+(SP)+2048,vpc1+(SP)+2048); SBAR(); \
    C0=M8(kf8[0],q8[0],negm); SBAR(); CV4(P0,0,0); PIN(pb); SBAR();        \
    C1=M8(kf8[2],q8[0],negm); SBAR(); CV4(P0,8,2); PIN(pb); SBAR(); \
    C0=M8(kf8[1],q8[1],C0);   SBAR(); CV4(P1,0,4); PIN(pb); SBAR(); \
    C1=M8(kf8[3],q8[1],C1);   SBAR(); CV4(P1,8,6); PIN(pb); SBAR(); \
    if(GK){DMA_K((t)+3,(SC));} if(GV){DMA_V((t)+1,(SN));} \
    CMASK(C0,C1,t); \
    if(!fx){ float a=MX3(C0[0],C0[1],C1[0]),b=MX3(C0[2],C0[3],C1[1]); a=MX3(a,C1[2],C1[3]); \
      _Pragma("unroll") for(int r=4;r<16;r+=4){a=MX3(a,C0[r],C0[r+1]);b=MX3(b,C0[r+2],C0[r+3]);a=MX3(a,C1[r],C1[r+1]);b=MX3(b,C1[r+2],C1[r+3]);} \
      float rm=__builtin_fmaxf(a,b); { auto rr=__builtin_amdgcn_permlane32_swap(__float_as_uint(rm),__float_as_uint(rm),false,false); rm=__builtin_fmaxf(__uint_as_float(rr[0]),__uint_as_float(rr[1])); } \
      rm-=POFF; resc=false; \
      if(__builtin_expect(__any(rm>(float)THRL),0)){ const float dl=__builtin_fmaxf(rm,0.f); mhat+=dl; \
        _Pragma("unroll") for(int r=0;r<16;++r){C0[r]-=dl;C1[r]-=dl;} \
        _Pragma("unroll") for(int r=0;r<16;++r)negm[r]=POFF-mhat; asm volatile("":"+v"(negm)); \
        const float f=__builtin_amdgcn_exp2f(-dl); if(hi==0)wsf[r32]=f; resc=true; } } \
    SBAR(); \
    o[0]=MPV(pb,vf0,o[0]); EX8(C0,0); SBAR(); \
    KRD(GL,0,SN); KRD(GL,1,SN); o[1]=MPV(pb,vf1,o[1]); EX8(C0,8); SBAR(); \
    KRD(GL,2,SN); KRD(GL,3,SN); ls4=MSUM(pb,onesm,ls4); EX8(C1,0); SBAR(); \
    EX8(C1,8); SBAR(); \
    }while(0)
  if(wid>=4)__builtin_amdgcn_s_setprio(1);
  int t=1;
  for(;t+9<NT;t+=6){
    STEP(pB0,pB1,pA0,pA1,t,  true,true,true,0,SLOTB,2*SLOTB);       WAIT_BAR(2); RESC();
    STEP(pA0,pA1,pB0,pB1,t+1,true,true,true,SLOTB,2*SLOTB,0);       WAIT_BAR(2); RESC();
    STEP(pB0,pB1,pA0,pA1,t+2,true,true,true,2*SLOTB,0,SLOTB);       WAIT_BAR(2); RESC();
    STEP(pA0,pA1,pB0,pB1,t+3,true,true,true,0,SLOTB,2*SLOTB);       WAIT_BAR(2); RESC();
    STEP(pB0,pB1,pA0,pA1,t+4,true,true,true,SLOTB,2*SLOTB,0);       WAIT_BAR(2); RESC();
    STEP(pA0,pA1,pB0,pB1,t+5,true,true,true,2*SLOTB,0,SLOTB);       WAIT_BAR(2); RESC();
  }
  #define ENDW(tt) do{ if((tt)+3<NT){WAIT_BAR(2);} else if((tt)+2<NT){WAIT_BAR(1);} else {WAIT_BAR(0);} }while(0)
  for(;t+1<NT;t+=2){
    STEP(pB0,pB1,pA0,pA1,t,(t+3<NT),(t+1<NT),(t+1<NT),sl_prev,sl_cur,sl_next);       ENDW(t);   RESC(); ROT();
    STEP(pA0,pA1,pB0,pB1,t+1,(t+4<NT),(t+2<NT),(t+2<NT),sl_prev,sl_cur,sl_next);     ENDW(t+1); RESC(); ROT();
  }
  STEP(pB0,pB1,pA0,pA1,NT-1,false,false,false,sl_prev,sl_cur,sl_next); RESC();
  { CV4(pB0,0,0); CV4(pB0,8,2); CV4(pB1,0,4); CV4(pB1,8,6); PIN(pb); SBAR();
    vf0=kfr(vpc0+sl_cur,vpc1+sl_cur); vf1=kfr(vpc0+sl_cur+2048,vpc1+sl_cur+2048);
    o[0]=MPV(pb,vf0,o[0]); o[1]=MPV(pb,vf1,o[1]); ls4=MSUM(pb,onesm,ls4); }
  #undef PIN
  #undef MX3
  #undef EX
  #undef PK8
  #undef CV4
  #undef EX8
  #undef KRD
  #undef KFRAG
  #undef STEP
  #undef ENDW
  __builtin_amdgcn_s_setprio(0);
  float lmin=__builtin_fminf(__builtin_fminf(ls4[0],ls4[1]),__builtin_fminf(ls4[2],ls4[3]));
  const bool sunk=fx&&__any(!(lmin>=1.0f));
  if((lane&7)==0){ wsf[32+lsq]=ls4[0]; wsf[32+lsq+1]=ls4[1]; wsf[32+lsq+2]=ls4[2]; wsf[32+lsq+3]=ls4[3]; } asm volatile("s_waitcnt lgkmcnt(0)":::"memory");
  float rli[16];
  #pragma unroll
  for(int r=0;r<16;++r)rli[r]=__builtin_amdgcn_rcpf(wsf[32+crow(r,hi)]);
  bf16*Ow=Ou+(long)wid*QBLK*OP;
  { bf16*stg=(bf16*)(shm+LDS_OST)+wid*2048;
    #pragma unroll
    for(int r=0;r<16;++r){const int orow=crow(r,hi);
      #pragma unroll
      for(int d0=0;d0<2;++d0)stg[orow*64+d0*32+r32]=(bf16)f2bf(o[d0][r]*rli[r]);}
    asm volatile("s_waitcnt lgkmcnt(0)":::"memory");
    #pragma unroll
    for(int i=0;i<4;++i){const int row=i*8+(lane>>3),ch=lane&7; const u32x4 v=*(const u32x4*)(stg+row*64+ch*8); ATTN_STORE16(Ow+(long)row*OP+ch*8,v);} }
  asm volatile("s_waitcnt lgkmcnt(0)\n\ts_barrier":::"memory");
  #undef DMA_K
  #undef DMA_V
  #undef CMASK
  #undef START
  #undef RESC
  #undef ROT
  return sunk;
}

#undef SBAR
#undef WAIT_BAR
constexpr int ATTN_LDS_BYTES=LDS_BYTES;
#undef M8
}


constexpr size_t MiB = 1u << 20;
constexpr size_t WS_CTL = 0, CTL_ZERO_BYTES = 1 * MiB;
constexpr size_t WS_MODS = 1 * MiB;
constexpr size_t WS_ROPE = WS_MODS + 256 * 1024;
constexpr size_t WS_PARAMS = WS_MODS + 320 * 1024;
constexpr int P_LN1G = 0, P_LN1B = 2048, P_LN2G = 4096, P_LN2B = 6144, P_QG = 8192, P_KG = 8256, P_WPOOL = 8320, P_PSC = 24704, P_QLG = 24960, P_KVLG = 25344, P_NAB = 25600, P_WR = 29440, P_BR = 37632, P_END = 37696;
static_assert(WS_PARAMS + (size_t)P_END * 4 <= WS_MODS + 512 * 1024, "params block");
constexpr size_t WS_X1C = WS_MODS + 512 * 1024;
constexpr size_t WS_ROUTE = 4 * MiB;
constexpr size_t WS_W0IN = 5 * MiB, WS_W0OUT = 8 * MiB, WS_W0GU = 10 * MiB, WS_W0D = 21 * MiB, WS_W1IN = 27 * MiB, WS_W1OUT = 32 * MiB, WS_WQ = 34 * MiB, WS_WKV = 35 * MiB;
constexpr size_t WS_SA = 36 * MiB;
constexpr size_t WS_H0 = WS_SA, WS_Q0 = WS_SA + 98 * MiB, WS_ACT0 = WS_SA, WS_H1RAW = WS_SA, WS_WEGU = WS_SA, WS_WED = WS_SA + 112 * MiB;
constexpr size_t WS_SB = 216 * MiB;
constexpr size_t WS_SC = 282 * MiB;
constexpr size_t WS_K0 = WS_SC, WS_V0 = WS_SC + 17 * MiB, WS_MIX0 = WS_SC + 34 * MiB, WS_Y0 = WS_SC + 100 * MiB, WS_U1 = WS_SC + 100 * MiB;
constexpr size_t WS_K1 = WS_SC, WS_Q1B = WS_SC + 33 * MiB, WS_V1 = WS_SC + 66 * MiB, WS_MIX1 = WS_SC + 100 * MiB, WS_H3 = WS_SC + 100 * MiB;
constexpr size_t WS_W8GU = WS_SA, WS_W8D = WS_SA + 56 * MiB, WS_XPAD = 120 * MiB, WS_ACT = 186 * MiB, WS_YPAD = 306 * MiB;
constexpr size_t WS_SCL = 464 * MiB, WS_SA_ROW = WS_SCL, WS_SA_SLOT = WS_SCL + 512 * 1024, WS_SW_0GU = WS_SCL + 1024 * 1024, WS_SW_0IN = WS_SW_0GU + 32 * 1024, WS_SW_1IN = WS_SW_0GU + 48 * 1024, WS_SW_EGU = WS_SCL + 1280 * 1024;
constexpr size_t WS_END = 466 * MiB;
static_assert(WS_H0 + (size_t)MA * N_IN0 * 2 <= WS_Q0 && WS_Q0 + (size_t)MA * 768 * 2 <= WS_SB, "SA layer-0 map");
static_assert(WS_ACT0 + (size_t)MA * FF0 * 2 <= WS_SB && WS_H1RAW + (size_t)MA * N_IN1 * 2 <= WS_SB, "SA map");
static_assert(WS_WEGU + (size_t)NEXP * 2 * FFE * DM * 2 <= WS_WED && WS_WED + (size_t)NEXP * DM * FFE * 2 <= WS_SB, "MoE weights map");
static_assert(WS_SB + (size_t)MA * DM * 2 <= WS_SC, "SB map");
static_assert(WS_K0 + (size_t)2 * NKEY * 256 * 2 <= WS_V0 && WS_V0 + (size_t)2 * NKEY * 256 * 2 <= WS_MIX0 && WS_MIX0 + (size_t)MA * DM * 2 <= WS_Y0, "SC layer-0 map");
static_assert(WS_K1 + (size_t)2 * NKEY * 1024 <= WS_Q1B && WS_Q1B + (size_t)MS * 1024 <= WS_V1 && WS_V1 + (size_t)2 * NKEY * 512 * 2 <= WS_MIX1, "SC layer-1 map");
static_assert(WS_W8GU + (size_t)NEXP * 2 * FFE * DM <= WS_W8D && WS_W8D + (size_t)NEXP * DM * FFE <= WS_XPAD && WS_XPAD + (size_t)MOE_TILES * 256 * DM <= WS_ACT && WS_ACT + (size_t)(MOE_TILES - MOE_CHUNK_TILES) * 256 * FFE <= WS_YPAD && WS_YPAD + (size_t)MOE_TILES * 256 * DM * 2 <= WS_SCL && WS_Y0 + (size_t)MA * DM * 2 <= WS_END, "MoE map");
static_assert(WS_W0IN + (size_t)N_IN0 * DM * 2 <= WS_W0OUT && WS_W0GU + (size_t)2 * FF0 * DM * 2 <= WS_W0D && WS_W0D + (size_t)DM * FF0 * 2 <= WS_W1IN && WS_W1IN + (size_t)N_IN1 * DM * 2 <= WS_W1OUT && WS_WKV + (size_t)1024 * 256 * 2 <= WS_SA, "weights map");
constexpr int CW_TMO = 0;
constexpr int CW_BAR = 4096;
constexpr int CW_KMAX = 8192;
constexpr int CW_CNT = 16384, CW_CUR = 16384 + 1024;

constexpr int RING_BYTES = 131072, LDSCTL_OFF = RING_BYTES, MISC_OFF = LDSCTL_OFF + 320, LDS_BYTES = 147456;
static_assert(att::L_END <= RING_BYTES && att64q8::ATTN_LDS_BYTES <= RING_BYTES && att96q8::ATTN_LDS_BYTES <= RING_BYTES, "attention LDS");

#define XB_TMO      128
#define XB_XCNT(j)  (256  + 64 * (j))
#define XB_XSUB(j)  (1280 + 64 * (j))
#define XB_XGEN(j)  (2304 + 64 * (j))
#define XB_TOP      3328
#define XB_TOPGEN   3392
#define XCD_BAR_WORDS 3456
#define XB_SPIN_CAP (1u << 18)
__device__ __forceinline__ unsigned xb_ld(unsigned* p)              { return __hip_atomic_load(p, __ATOMIC_RELAXED, __HIP_MEMORY_SCOPE_AGENT); }
__device__ __forceinline__ unsigned xb_add(unsigned* p, unsigned v) { return __hip_atomic_fetch_add(p, v, __ATOMIC_RELAXED, __HIP_MEMORY_SCOPE_AGENT); }
__device__ __forceinline__ unsigned xb_xcc_id() { return (unsigned)__builtin_amdgcn_s_getreg((3 << 11) | 20) & 0xFu; }
#define XB_SPIN(cond, bar) do { unsigned _sp = 0; while (cond) { __builtin_amdgcn_s_sleep(1); \
    if ((++_sp & 255u) == 0u) { if (xb_ld(&(bar)[XB_TMO])) break; if (_sp > XB_SPIN_CAP) { atomicAdd(&(bar)[XB_TMO], 1u); break; } } } } while (0)
struct XcdBarrier { unsigned* bar; unsigned x; volatile LAS unsigned* st; };
__device__ __forceinline__ XcdBarrier xcd_barrier_post(unsigned* bar, volatile LAS unsigned* st) {
    XcdBarrier b; b.bar = bar; b.x = xb_xcc_id(); b.st = st;
    if (threadIdx.x == 0) (void)xb_add(&bar[XB_XCNT(b.x)], 1u);
    return b;
}
__device__ __forceinline__ void xcd_barrier_complete(unsigned* bar, unsigned x, unsigned& nloc, unsigned& nx) {
    const unsigned G = gridDim.x * gridDim.y * gridDim.z;
    unsigned sum, cnt, mine, sp = 0u;
    for (;;) {
        sum = 0u; cnt = 0u; mine = 0u;
#pragma unroll
        for (unsigned j = 0; j < 16; ++j) { const unsigned c = xb_ld(&bar[XB_XCNT(j)]); sum += c; cnt += (c > 0u) ? 1u : 0u; mine = (j == x) ? c : mine; }
        if (sum == G) break;
        __builtin_amdgcn_s_sleep(1);
        if ((++sp & 255u) == 0u) { if (xb_ld(&bar[XB_TMO])) break; if (sp > XB_SPIN_CAP) { atomicAdd(&bar[XB_TMO], 1u); break; } }
    }
    nloc = mine > 0u ? mine : 1u; nx = cnt > 0u ? cnt : 1u;
}
__device__ __forceinline__ void xcd_barrier(const XcdBarrier& b) {
    asm volatile("s_waitcnt vmcnt(0)" ::: "memory");
    __syncthreads();
    if (threadIdx.x == 0) {
        unsigned* bar = b.bar;
        __builtin_amdgcn_s_waitcnt(0);
        unsigned nloc = b.st[0], nx = b.st[1];
        if (nloc == 0u) { xcd_barrier_complete(bar, b.x, nloc, nx); b.st[0] = nloc; b.st[1] = nx; }
        const unsigned old = xb_add(&bar[XB_XSUB(b.x)], 1u);
        const unsigned gen = old / nloc;
        if (old + 1u == (gen + 1u) * nloc) {
            __builtin_amdgcn_fence(__ATOMIC_RELEASE, "agent");
            asm volatile("s_waitcnt vmcnt(0)" ::: "memory");
            const unsigned og = xb_add(&bar[XB_TOP], 1u);
            const unsigned tg = og / nx;
            if (og + 1u == (tg + 1u) * nx) xb_add(&bar[XB_TOPGEN], 1u);
            else XB_SPIN(xb_ld(&bar[XB_TOPGEN]) == tg, bar);
            __builtin_amdgcn_fence(__ATOMIC_ACQUIRE, "agent");
            xb_add(&bar[XB_XGEN(b.x)], 1u);
            asm volatile("s_waitcnt vmcnt(0)" ::: "memory");
        } else {
            XB_SPIN(xb_ld(&bar[XB_XGEN(b.x)]) == gen, bar);
            __builtin_amdgcn_fence(__ATOMIC_ACQUIRE, "agent");
            asm volatile("s_waitcnt vmcnt(0)" ::: "memory");
        }
    }
    __syncthreads();
}

__device__ __forceinline__ void cvt_item(const float* src, int ldsrc, int scol0, int k0, bf16* dst, int K, int drow0, float scale, LAS float* scr, int lane) {
    const int kr = lane >> 3, c4 = lane & 7;
    f32x4 v[8];
#pragma unroll
    for (int i = 0; i < 8; ++i) v[i] = src ? *(const f32x4*)(src + (size_t)(k0 + 8 * i + kr) * ldsrc + scol0 + 4 * c4) : (f32x4){0.f, 0.f, 0.f, 0.f};
#pragma unroll
    for (int i = 0; i < 8; ++i) { LAS float* p = scr + (8 * i + kr) * 33 + 4 * c4; p[0] = v[i][0] * scale; p[1] = v[i][1] * scale; p[2] = v[i][2] * scale; p[3] = v[i][3] * scale; }
    LDS_WAIT(); asm volatile("" ::: "memory");
    const int c = lane & 7;
#pragma unroll
    for (int j = 0; j < 4; ++j) { const int n = (lane >> 3) + 8 * j; const LAS float* sp = scr + (8 * c) * 33 + n;
        u32x4 o; o.x = pk2(sp[0 * 33], sp[1 * 33]); o.y = pk2(sp[2 * 33], sp[3 * 33]); o.z = pk2(sp[4 * 33], sp[5 * 33]); o.w = pk2(sp[6 * 33], sp[7 * 33]);
        *(u32x4*)(dst + (size_t)(drow0 + n) * K + k0 + 8 * c) = o; }
    LDS_WAIT(); asm volatile("" ::: "memory");
}
__device__ __forceinline__ void cvt_item8(const float* src, int ldsrc, int scol0, int k0, unsigned char* dst, int K, int drow0, float scale, LAS float* scr, int lane) {
    const int kr = lane >> 3, c4 = lane & 7;
    f32x4 v[8];
#pragma unroll
    for (int i = 0; i < 8; ++i) v[i] = *(const f32x4*)(src + (size_t)(k0 + 8 * i + kr) * ldsrc + scol0 + 4 * c4);
#pragma unroll
    for (int i = 0; i < 8; ++i) { LAS float* p = scr + (8 * i + kr) * 33 + 4 * c4; p[0] = v[i][0] * scale; p[1] = v[i][1] * scale; p[2] = v[i][2] * scale; p[3] = v[i][3] * scale; }
    LDS_WAIT(); asm volatile("" ::: "memory");
    const int c = lane & 7;
#pragma unroll
    for (int j = 0; j < 4; ++j) { const int n = (lane >> 3) + 8 * j; const LAS float* sp = scr + (8 * c) * 33 + n;
        int w0 = 0, w1 = 0; w0 = __builtin_amdgcn_cvt_pk_fp8_f32(sp[0 * 33], sp[1 * 33], w0, false); w0 = __builtin_amdgcn_cvt_pk_fp8_f32(sp[2 * 33], sp[3 * 33], w0, true);
        w1 = __builtin_amdgcn_cvt_pk_fp8_f32(sp[4 * 33], sp[5 * 33], w1, false); w1 = __builtin_amdgcn_cvt_pk_fp8_f32(sp[6 * 33], sp[7 * 33], w1, true);
        u32x2 o; o.x = (unsigned)w0; o.y = (unsigned)w1; *(u32x2*)(dst + (size_t)(drow0 + n) * K + k0 + 8 * c) = o; }
    LDS_WAIT(); asm volatile("" ::: "memory");
}
__device__ __forceinline__ unsigned pk_i8(float a, float b, float c, float d) {
    const int q0 = (int)__builtin_rintf(a), q1 = (int)__builtin_rintf(b), q2 = (int)__builtin_rintf(c), q3 = (int)__builtin_rintf(d);
    return (unsigned)(q0 & 255) | ((unsigned)(q1 & 255) << 8) | ((unsigned)(q2 & 255) << 16) | ((unsigned)q3 << 24); }
__device__ __forceinline__ void cvt_strip_i8(const float* src, int ldsrc, int scol0, int K, unsigned char* dst, int drow0, float* sw, float wscale, LAS float* scr, int lane) {
    const int kr = lane >> 3, c4 = lane & 7;
    if (!src) {
        for (int k0 = 0; k0 < K; k0 += 64) {
#pragma unroll
            for (int j = 0; j < 4; ++j) *(u32x2*)(dst + (size_t)(drow0 + (lane >> 3) + 8 * j) * K + k0 + 8 * (lane & 7)) = (u32x2){0u, 0u}; }
        if (kr == 0) *(f32x4*)(sw + drow0 + 4 * c4) = (f32x4){0.f, 0.f, 0.f, 0.f};
        return; }
    f32x4 mx = {0.f, 0.f, 0.f, 0.f};
#pragma unroll 2
    for (int k0 = 0; k0 < K; k0 += 64) {
        f32x4 v[8];
#pragma unroll
        for (int i = 0; i < 8; ++i) v[i] = *(const f32x4*)(src + (size_t)(k0 + 8 * i + kr) * ldsrc + scol0 + 4 * c4);
#pragma unroll
        for (int i = 0; i < 8; ++i) { mx[0] = fmaxf(mx[0], fabsf(v[i][0])); mx[1] = fmaxf(mx[1], fabsf(v[i][1])); mx[2] = fmaxf(mx[2], fabsf(v[i][2])); mx[3] = fmaxf(mx[3], fabsf(v[i][3])); }
    }
#pragma unroll
    for (int o = 8; o < 64; o <<= 1) { mx[0] = fmaxf(mx[0], shx(mx[0], o)); mx[1] = fmaxf(mx[1], shx(mx[1], o)); mx[2] = fmaxf(mx[2], shx(mx[2], o)); mx[3] = fmaxf(mx[3], shx(mx[3], o)); }
    f32x4 inv;
#pragma unroll
    for (int j = 0; j < 4; ++j) inv[j] = mx[j] > 0.f ? 127.0f / mx[j] : 0.f;
    if (kr == 0) *(f32x4*)(sw + drow0 + 4 * c4) = mx * (wscale / 127.0f);
#pragma unroll 1
    for (int k0 = 0; k0 < K; k0 += 64) {
        f32x4 v[8];
#pragma unroll
        for (int i = 0; i < 8; ++i) v[i] = *(const f32x4*)(src + (size_t)(k0 + 8 * i + kr) * ldsrc + scol0 + 4 * c4);
#pragma unroll
        for (int i = 0; i < 8; ++i) { LAS float* p = scr + (8 * i + kr) * 33 + 4 * c4; p[0] = v[i][0] * inv[0]; p[1] = v[i][1] * inv[1]; p[2] = v[i][2] * inv[2]; p[3] = v[i][3] * inv[3]; }
        LDS_WAIT(); asm volatile("" ::: "memory");
        const int c = lane & 7;
#pragma unroll
        for (int j = 0; j < 4; ++j) { const int n = (lane >> 3) + 8 * j; const LAS float* sp = scr + (8 * c) * 33 + n;
            u32x2 o; o.x = pk_i8(sp[0 * 33], sp[1 * 33], sp[2 * 33], sp[3 * 33]); o.y = pk_i8(sp[4 * 33], sp[5 * 33], sp[6 * 33], sp[7 * 33]);
            *(u32x2*)(dst + (size_t)(drow0 + n) * K + k0 + 8 * c) = o; }
        LDS_WAIT(); asm volatile("" ::: "memory");
    }
}
__device__ __forceinline__ void build_vt_images(const bf16* V, int vpitch, int nheads, unsigned char* out, int gw_, int ngw_, LAS unsigned char* img, int lane) {
    const int k5 = lane & 31, g_ = (k5 >> 2) & 1, pos = g_ * 32 + (k5 & 3) + 4 * (k5 >> 3) + 16 * (lane >> 5), ch = pos >> 4, by = pos & 15;
    for (int it = gw_; it < 2 * nheads * (NKEY / 64); it += ngw_) {
        const int bk = it / (NKEY / 64), t = it - bk * (NKEY / 64); const int b = bk / nheads, hd = bk - b * nheads;
        const bf16* src = V + (size_t)(b * NKEY + t * 64 + lane) * vpitch + hd * 64;
        u32x4 v[8];
#pragma unroll
        for (int i = 0; i < 8; ++i) v[i] = *(const u32x4*)(src + 8 * i);
#pragma unroll
        for (int i = 0; i < 8; ++i) {
#pragma unroll
            for (int j = 0; j < 4; ++j) { const unsigned w = j == 0 ? v[i].x : j == 1 ? v[i].y : j == 2 ? v[i].z : v[i].w; const int d = 8 * i + 2 * j;
                const int p8 = __builtin_amdgcn_cvt_pk_fp8_f32(__uint_as_float(w << 16), __uint_as_float(w & 0xffff0000u), 0, false);
                LAS unsigned char* q = img + ((ch ^ ((d >> 2) & 3)) << 4) + by;
                q[d * 64] = (unsigned char)(p8 & 255); q[(d + 1) * 64] = (unsigned char)((p8 >> 8) & 255); } }
        LDS_WAIT(); asm volatile("" ::: "memory");
        unsigned char* dst = out + (size_t)it * 4096 + lane * 64;
#pragma unroll
        for (int i = 0; i < 4; ++i) *(u32x4*)(dst + 16 * i) = *(const LAS u32x4*)(img + lane * 64 + 16 * i);
        LDS_WAIT(); asm volatile("" ::: "memory");
    }
}
struct Row16 { f32x4 v[4]; };
__device__ __forceinline__ Row16 ld_row_f32(const float* p, int lane) { Row16 r; const f32x4* q = (const f32x4*)p + lane;
#pragma unroll
    for (int j = 0; j < 4; ++j) r.v[j] = q[64 * j];
    return r; }
__device__ __forceinline__ Row16 ld_row_bf16(const bf16* p, int lane) { Row16 r; const u32x2* q = (const u32x2*)p + lane;
#pragma unroll
    for (int j = 0; j < 4; ++j) { const u32x2 w = q[64 * j]; r.v[j] = (f32x4){__uint_as_float(w.x << 16), __uint_as_float(w.x & 0xffff0000u), __uint_as_float(w.y << 16), __uint_as_float(w.y & 0xffff0000u)}; }
    return r; }
__device__ __forceinline__ void st_row_f32(float* p, int lane, const Row16& r) { f32x4* q = (f32x4*)p + lane;
#pragma unroll
    for (int j = 0; j < 4; ++j) __builtin_nontemporal_store(r.v[j], q + 64 * j); }
__device__ __forceinline__ void st_row_bf16(bf16* p, int lane, const Row16& r) { u32x2* q = (u32x2*)p + lane;
#pragma unroll
    for (int j = 0; j < 4; ++j) { u32x2 w; w.x = pk2(r.v[j][0], r.v[j][1]); w.y = pk2(r.v[j][2], r.v[j][3]); q[64 * j] = w; } }
__device__ __forceinline__ void st_row_i8(unsigned char* p, float* sa, int lane, const Row16& r) { unsigned* q = (unsigned*)p + lane;
    float am = 0.f;
#pragma unroll
    for (int j = 0; j < 4; ++j) am = fmaxf(fmaxf(am, fmaxf(fabsf(r.v[j][0]), fabsf(r.v[j][1]))), fmaxf(fabsf(r.v[j][2]), fabsf(r.v[j][3])));
    am = wave_max(am); const float inv = am > 0.f ? 127.0f / am : 0.f;
    if (lane == 0) *sa = am * (1.0f / 127.0f);
#pragma unroll
    for (int j = 0; j < 4; ++j) q[64 * j] = pk_i8(r.v[j][0] * inv, r.v[j][1] * inv, r.v[j][2] * inv, r.v[j][3] * inv); }
__device__ __forceinline__ void st_row_fp8(unsigned char* p, int lane, const Row16& r, float sc) { unsigned* q = (unsigned*)p + lane;
#pragma unroll
    for (int j = 0; j < 4; ++j) { int w_ = 0; w_ = __builtin_amdgcn_cvt_pk_fp8_f32(r.v[j][0] * sc, r.v[j][1] * sc, w_, false); w_ = __builtin_amdgcn_cvt_pk_fp8_f32(r.v[j][2] * sc, r.v[j][3] * sc, w_, true); q[64 * j] = (unsigned)w_; } }
__device__ __forceinline__ void ln_row(Row16& z, const float* g, const float* b, int lane) {
    float s = 0.f;
#pragma unroll
    for (int j = 0; j < 4; ++j) s += (z.v[j][0] + z.v[j][1]) + (z.v[j][2] + z.v[j][3]);
    const float mean = wave_sum(s) * (1.f / DM); float s2 = 0.f;
#pragma unroll
    for (int j = 0; j < 4; ++j) { z.v[j] = z.v[j] - mean; s2 += (z.v[j][0] * z.v[j][0] + z.v[j][1] * z.v[j][1]) + (z.v[j][2] * z.v[j][2] + z.v[j][3] * z.v[j][3]); }
    const float rstd = 1.0f / sqrtf(wave_sum(s2) * (1.f / DM) + EPS);
    const Row16 gg = ld_row_f32(g, lane), bb = ld_row_f32(b, lane);
#pragma unroll
    for (int j = 0; j < 4; ++j) z.v[j] = z.v[j] * rstd * gg.v[j] + bb.v[j];
}
__device__ __forceinline__ void ln_row2(Row16& z, const Row16& gg, const Row16& bb) {
    float s = 0.f;
#pragma unroll
    for (int j = 0; j < 4; ++j) s += (z.v[j][0] + z.v[j][1]) + (z.v[j][2] + z.v[j][3]);
    const float mean = wave_sum(s) * (1.f / DM); float s2 = 0.f;
#pragma unroll
    for (int j = 0; j < 4; ++j) { z.v[j] = z.v[j] - mean; s2 += (z.v[j][0] * z.v[j][0] + z.v[j][1] * z.v[j][1]) + (z.v[j][2] * z.v[j][2] + z.v[j][3] * z.v[j][3]); }
    const float rstd = 1.0f / sqrtf(wave_sum(s2) * (1.f / DM) + EPS);
#pragma unroll
    for (int j = 0; j < 4; ++j) z.v[j] = z.v[j] * rstd * gg.v[j] + bb.v[j];
}
struct RowIn { f32x4 x[4]; u32x2 y[4]; };
__device__ __forceinline__ RowIn ld_rowin(const float* xp, const bf16* yp, int lane) { RowIn r; const f32x4* q = (const f32x4*)xp + lane; const u32x2* p = (const u32x2*)yp + lane;
#pragma unroll
    for (int j = 0; j < 4; ++j) { r.x[j] = q[64 * j]; r.y[j] = p[64 * j]; }
    return r; }
__device__ __forceinline__ f32x4 bf4(const u32x2 w) { return (f32x4){__uint_as_float(w.x << 16), __uint_as_float(w.x & 0xffff0000u), __uint_as_float(w.y << 16), __uint_as_float(w.y & 0xffff0000u)}; }
__device__ __forceinline__ Row16 modulate(const Row16& x, const float* shift, const float* scale, int lane) {
    const Row16 sh = ld_row_f32(shift, lane), sc = ld_row_f32(scale, lane); Row16 r;
#pragma unroll
    for (int j = 0; j < 4; ++j) r.v[j] = x.v[j] * (1.0f + sc.v[j]) + sh.v[j];
    return r;
}

enum { I_X = 0, I_C, I_CTX, I_CCTX, I_WADA, I_BADA, I_LN1G, I_LN1B, I_LN2G, I_LN2B, I_EVWIN, I_EVWOUT, I_EVQG, I_EVKG, I_EVWPOOL, I_EVPSCALE, I_EVWG, I_EVWU, I_EVWD,
       I_ODWIN, I_ODWOUT, I_ODQLG, I_ODKVLG, I_ODWQUP, I_ODWKVUP, I_ODNABIAS, I_ODWR, I_ODBR, I_ODWG, I_ODWU, I_ODWD, N_INPUTS };
constexpr int N_PHASES = 29;
struct Args { const float* in[N_INPUTS]; float* out; unsigned char* ws; int ph_lo, ph_hi; };

__global__ void __launch_bounds__(512, 2) fwd_kernel(Args args) {
    extern __shared__ __attribute__((aligned(16))) unsigned char lds_raw[];
    LAS unsigned char* lds = (LAS unsigned char*)lds_raw;
    volatile LAS unsigned* MISC = (volatile LAS unsigned*)(lds + MISC_OFF);
    const int wave = __builtin_amdgcn_readfirstlane((int)threadIdx.x >> 6);
#define G ((int)gridDim.x)
#define bx ((int)blockIdx.x)
#define vcu ((bx % 8) * (G / 8) + bx / 8)
#define gw (vcu * 8 + wave)
#define NGW (G * 8)
    unsigned char* ws = args.ws;
    gu32* ctl = (gu32*)(ws + WS_CTL);
    for (int u = wave * 64 + lane_id(); u < (LDS_BYTES - LDSCTL_OFF) / 4; u += 512) ((LAS unsigned*)(lds + LDSCTL_OFF))[u] = 0u;
    __syncthreads();
    if (!MK_PER_PHASE) (void)xcd_barrier_post((unsigned*)(ctl + CW_BAR), MISC + 8);
#define BAR_NOW() XcdBarrier{(unsigned*)((gu32*)(args.ws + WS_CTL) + CW_BAR), xb_xcc_id(), (volatile LAS unsigned*)(lds + MISC_OFF) + 8}
#if MK_PER_PHASE || PROBE_K > 0
    const int lo = args.ph_lo, hi = args.ph_hi;
#else
    constexpr int lo = 0, hi = N_PHASES + 1;
#endif
#define WG_ANY(p_) ([&]() -> bool { __syncthreads(); if (wave == 0 && lane_id() == 0) MISC[24] = 0u; __syncthreads(); if ((p_) && lane_id() == 0) MISC[24] = 1u; __syncthreads(); return MISC[24] != 0u; }())
#define IN(k) (lo <= (k) && (k) < hi)
#define SEAM(k) do { if (IN(k) && IN((k) + 1)) xcd_barrier(BAR_NOW()); } while (0)

#define PRM(off) ((const float*)(ws + WS_PARAMS) + (off))
#define x_in (args.in[I_X])
#define ctx_in (args.in[I_CTX])
#define out (args.out)
#define mods ((float*)(ws + WS_MODS))
#define cos16 ((float*)(ws + WS_ROPE))
#define sin16 (cos16 + 4096)
#define cos8 (cos16 + 8192)
#define sin8 (cos16 + 8192 + 2048)
#define x1c ((float*)(ws + WS_X1C))
#define r_dest ((int*)(ws + WS_ROUTE))
#define r_gate ((float*)(ws + WS_ROUTE + 256 * 1024))
#define r_exp ((int*)(ws + WS_ROUTE + 512 * 1024))
#define wgcnt ((int*)(ws + WS_ROUTE + 768 * 1024))
#define W0IN8 ((unsigned char*)(ws + WS_W0IN))
#define SW_0IN ((float*)(ws + WS_SW_0IN))
#define W0OUT ((bf16*)(ws + WS_W0OUT))
#define W0GU8 ((unsigned char*)(ws + WS_W0GU))
#define SA_ROW ((float*)(ws + WS_SA_ROW))
#define SW_0GU ((float*)(ws + WS_SW_0GU))
#define W0D8 ((unsigned char*)(ws + WS_W0D))
#define W1IN8 ((unsigned char*)(ws + WS_W1IN))
#define SW_1IN ((float*)(ws + WS_SW_1IN))
#define W1OUT ((bf16*)(ws + WS_W1OUT))
#define WQ ((bf16*)(ws + WS_WQ))
#define WKV ((bf16*)(ws + WS_WKV))
#define WEGU ((bf16*)(ws + WS_WEGU))
#define WED ((bf16*)(ws + WS_WED))
#define U08 ((unsigned char*)(ws + WS_SB))
#define H18 ((unsigned char*)(ws + WS_SB))
#define Y0B ((bf16*)(ws + WS_SB))
#define Q1 ((bf16*)(ws + WS_SB))
#define Y1 ((bf16*)(ws + WS_SB))
#define PB ((bf16*)(ws + WS_H0))
#define Q0 ((bf16*)(ws + WS_Q0))
#define ACT08 ((unsigned char*)(ws + WS_ACT0))
#define H1RAW ((bf16*)(ws + WS_H1RAW))
#define K0 ((bf16*)(ws + WS_K0))
#define V0 ((bf16*)(ws + WS_V0))
#define V1T8 ((unsigned char*)(ws + 186 * MiB))
#define V0T8 ((unsigned char*)(ws + WS_SA + 32 * MiB))
#define MIX0 ((bf16*)(ws + WS_MIX0))
#define Y0 ((bf16*)(ws + WS_Y0))
#define U18 ((unsigned char*)(ws + WS_U1))
#define K1 ((bf16*)(ws + WS_K1))
#define V1 ((bf16*)(ws + WS_V1))
#define K1B ((unsigned char*)(ws + WS_K1))
#define Q1B ((unsigned char*)(ws + WS_Q1B))
#define MIX1 ((bf16*)(ws + WS_MIX1))
#define H3 ((bf16*)(ws + WS_H3))
#define XPAD8 ((unsigned char*)(ws + WS_XPAD))
#define ACT8 ((unsigned char*)(ws + WS_ACT))
#define YPAD ((bf16*)(ws + WS_YPAD))
#define W8GU ((unsigned char*)(ws + WS_W8GU))
#define W8D ((unsigned char*)(ws + WS_W8D))
#define H3B ((unsigned char*)(ws + WS_H3))
#define ACT ((bf16*)(ws + WS_ACT))

    if (IN(0)) { const int lane = lane_id(); const int tid = wave * 64 + lane; (void)tid;
        LAS float* scr = (LAS float*)(lds + wave * 16384);
        {
            constexpr int I0 = 16 * (N_IN0 / 32), I1 = 16 * 32, I2 = 16 * (2 * FF0 / 32), I3 = (FF0 / 64) * 32, I4 = 16 * (N_IN1 / 32), I5 = 16 * 32, I6 = 6 * 24, I7 = 4 * 32;
            constexpr int NST = 2 * FF0 / 32;
            constexpr int NIT = NST + N_IN0 / 32 + N_IN1 / 32 + I1 + I3 + I5 + I6 + I7;
            for (int it = gw; it < NIT; it += NGW) {
                int r = it;
                if (r < NST) { const int j0 = 32 * r, pn = j0 >> 8, half = (j0 >> 7) & 1, i = j0 & 127;
                    cvt_strip_i8(half ? args.in[I_EVWU] : args.in[I_EVWG], FF0, 128 * pn + i, DM, W0GU8, j0, SW_0GU, 1.f, scr, lane); continue; } r -= NST;
                if (r < N_IN0 / 32) { const int j0 = 32 * r, pn = j0 >> 8, tc0 = j0 & 255;
                    const int sc = (pn < 4) ? ((pn < 3 ? pn * 256 : 768) + ((tc0 & 127) >> 5) * 64 + (tc0 >> 7) * 32) : j0;
                    cvt_strip_i8(args.in[I_EVWIN], N_IN0, sc, DM, W0IN8, j0, SW_0IN, 1.f, scr, lane); continue; } r -= N_IN0 / 32;
                if (r < N_IN1 / 32) { const int j0 = 32 * r; int sc = -1; float s_ = 1.f;
                    if (j0 < C1_NQ) sc = j0; else if (j0 < C1_NK) { sc = 672 + (j0 - C1_NQ); s_ = SC64; } else if (j0 < C1_NV) sc = 1184 + (j0 - C1_NK); else if (j0 < C1_KR) sc = 1696 + (j0 - C1_NV); else if (j0 == C1_KR) sc = 640;
                    cvt_strip_i8(sc >= 0 ? args.in[I_ODWIN] : nullptr, 2208, sc >= 0 ? sc : 0, DM, W1IN8, j0, SW_1IN, s_, scr, lane); continue; } r -= N_IN1 / 32;
                if (r < I1) { const int kb = r / 32, nb = r % 32; cvt_item(args.in[I_EVWOUT], DM, 32 * nb, 64 * kb, W0OUT, DM, 32 * nb, 1.f, scr, lane); continue; } r -= I1;
                if (r < I3) { const int kb = r / 32, nb = r % 32; cvt_item8(args.in[I_EVWD], DM, 32 * nb, 64 * kb, W0D8, FF0, 32 * nb, 128.f, scr, lane); continue; } r -= I3;
                if (r < I5) { const int kb = r / 32, nb = r % 32; cvt_item(args.in[I_ODWOUT], DM, 32 * nb, 64 * kb, W1OUT, DM, 32 * nb, 1.f, scr, lane); continue; } r -= I5;
                if (r < I6) { const int kb = r / 24, nb = r % 24; cvt_item(args.in[I_ODWQUP], 768, 32 * nb, 64 * kb, WQ, 384, 32 * nb, SC96, scr, lane); continue; } r -= I6;
                { const int kb = r / 32, nb = r % 32; const int j0 = 32 * nb; const int sc = (j0 < 512) ? ((j0 >> 6) * 128 + (j0 & 63)) : (((j0 - 512) >> 6) * 128 + 64 + (j0 & 63));
                    cvt_item(args.in[I_ODWKVUP], 1024, sc, 64 * kb, WKV, 256, j0, 1.f, scr, lane); }
            }
        }
        __syncthreads();
        {
            LAS float* sv = (LAS float*)(lds + 0);
            LAS float* part = (LAS float*)(lds + 16384);
            for (int i = tid; i < 3 * 1024; i += 512) { const int v = i >> 10, k = i & 1023; const float c = (v < 2) ? args.in[I_C][v * 1024 + k] : args.in[I_CCTX][k]; sv[i] = c / (1.0f + __expf(-c)); }
            __syncthreads();
            for (int un = bx; un < 2 * 96; un += G) {
                const int l = un / 96, cb = un % 96; const int col = cb * 64 + (tid & 63), kq = tid >> 6;
                const float* W = args.in[I_WADA] + (size_t)l * 1024 * 6144 + col;
                float a0 = 0.f, a1 = 0.f, a2 = 0.f;
#pragma unroll 32
                for (int k = kq * 128; k < kq * 128 + 128; ++k) { const float w = W[(size_t)k * 6144]; a0 += sv[k] * w; a1 += sv[1024 + k] * w; a2 += sv[2048 + k] * w; }
                part[(kq * 3 + 0) * 64 + (tid & 63)] = a0; part[(kq * 3 + 1) * 64 + (tid & 63)] = a1; part[(kq * 3 + 2) * 64 + (tid & 63)] = a2;
                __syncthreads();
                if (tid < 192) { const int v = tid >> 6, c = tid & 63; float s = 0.f;
#pragma unroll
                    for (int q = 0; q < 8; ++q) s += part[(q * 3 + v) * 64 + c];
                    mods[((size_t)l * 3 + v) * 6144 + cb * 64 + c] = s + args.in[I_BADA][l * 6144 + cb * 64 + c]; }
                __syncthreads();
            }
        }
        {
#define CP_(I_, off_, n_) for (int i = bx * 512 + tid; i < (n_); i += G * 512) ((float*)(ws + WS_PARAMS))[(off_) + i] = args.in[I_][i];
            CP_(I_LN1G, P_LN1G, 2048) CP_(I_LN1B, P_LN1B, 2048) CP_(I_LN2G, P_LN2G, 2048) CP_(I_LN2B, P_LN2B, 2048) CP_(I_EVQG, P_QG, 64) CP_(I_EVKG, P_KG, 64) CP_(I_EVWPOOL, P_WPOOL, 16384)
            CP_(I_EVPSCALE, P_PSC, 256) CP_(I_ODQLG, P_QLG, 384) CP_(I_ODKVLG, P_KVLG, 256) CP_(I_ODNABIAS, P_NAB, 3720) CP_(I_ODWR, P_WR, 8192) CP_(I_ODBR, P_BR, 8)
#undef CP_
        }
        {
            const int gt = bx * 512 + tid;
            if (gt < 4096) { const int pos = gt >> 4, i = gt & 15; const float inv = powf(10000.0f, -(float)i / 16.0f); const float a = (float)pos * inv; cos16[gt] = cosf(a); sin16[gt] = sinf(a); }
            else if (gt < 4096 + 2048) { const int g2 = gt - 4096, pos = g2 >> 3, i = g2 & 7; const float inv = powf(10000.0f, -(float)i / 8.0f); const float a = (float)pos * inv; cos8[g2] = cosf(a); sin8[g2] = sinf(a); }
        }
    }
    SEAM(0);

    if (IN(1)) { const int lane = lane_id(); const int tid = wave * 64 + lane; (void)tid;
#define P1_SRC(m_) (((m_) < MS) ? x_in + (size_t)(m_) * DM : ctx_in + (size_t)((m_) - MS) * DM)
        Row16 SH, SC; int vcur = -1;
        int m = gw; Row16 x0 = ld_row_f32(P1_SRC(m), lane), x1, x2;
        { const int m1 = m + NGW, m2 = m + 2 * NGW; if (m1 < MA) x1 = ld_row_f32(P1_SRC(m1), lane); if (m2 < MA) x2 = ld_row_f32(P1_SRC(m2), lane); }
        for (; m < MA; m += NGW) {
            const Row16 xr = x0; x0 = x1; x1 = x2; const int m3 = m + 3 * NGW;
            if (m3 < MA) x2 = ld_row_f32(P1_SRC(m3), lane);
            const int v = (m < MS) ? (m >> 14) : 2;
            if (v != vcur) { const float* md = mods + (size_t)(0 * 3 + v) * 6144; SH = ld_row_f32(md, lane); SC = ld_row_f32(md + 1024, lane); vcur = v; }
            Row16 u;
#pragma unroll
            for (int j = 0; j < 4; ++j) u.v[j] = xr.v[j] * (1.0f + SC.v[j]) + SH.v[j];
            st_row_i8(U08 + (size_t)m * DM, SA_ROW + m, lane, u);
        }
#undef P1_SRC
    }
    SEAM(1);

    if (IN(2)) { const int lane = lane_id(); const int tid = wave * 64 + lane; (void)tid;
        pg8::Gemm g{U08, W0IN8, DM, DM, 0, SA_ROW, SW_0IN, 0}; pg8::StaticOrder S; S.init(MA / 256, N_IN0 / 256, G, bx);
        pg8::EpiQKV E{ws, WS_Q0, WS_K0, WS_V0, WS_H0, WS_ROPE, PRM(P_QG), PRM(P_KG)};
        for (int rep = 0; rep < REP_G; ++rep) pg8::gemm_phase<pg8::EpiQKV, pg8::StaticOrder, 2>(lds, g, S, E, wave);
    }
    SEAM(2);

    if (IN(3)) { const int lane = lane_id(); build_vt_images(V0, 256, 4, V0T8, gw, NGW, (LAS unsigned char*)lds + wave * 4096, lane); }
    SEAM(3);

    if (IN(4)) { const int lane = lane_id(); const int tid = wave * 64 + lane; (void)tid;
        {
            LAS float* wp = (LAS float*)lds;
            for (int i = tid; i < 4 * 64 * 64; i += 512) wp[i] = PRM(P_WPOOL)[i];
            __syncthreads();
            const float* psc = PRM(P_PSC);
#define POOL_G(g) { bf16x8 wfr[2][4];        \
                _Pragma("unroll") for (int s_ = 0; s_ < 2; ++s_) _Pragma("unroll") for (int nb = 0; nb < 4; ++nb) { \
                    const LAS float* wq = wp + ((g) * 64 + 32 * s_ + 8 * (lane >> 4)) * 64 + 16 * nb + (lane & 15); \
                    u32x4 t_; t_.x = pk2(wq[0], wq[64]); t_.y = pk2(wq[128], wq[192]); t_.z = pk2(wq[256], wq[320]); t_.w = pk2(wq[384], wq[448]); \
                    wfr[s_][nb] = __builtin_bit_cast(bf16x8, t_); } \
                float ps4[4]; _Pragma("unroll") for (int nb = 0; nb < 4; ++nb) ps4[nb] = psc[(g) * 64 + 16 * nb + (lane & 15)]; \
                LAS bf16* yb = (LAS bf16*)(lds + 65536 + wave * 2304);          \
                for (int rep = 0; rep < REP_POOL; ++rep) for (int blk = gw; blk < MA / 16; blk += NGW) { \
                const int m0 = blk * 16; const bool isseq = m0 < MS; const int L = isseq ? SEQ : CTX; const int pos0 = isseq ? (m0 & (SEQ - 1)) : ((m0 - MS) & 255); \
                    { constexpr int LO = 1 << (g), NV = 16 + 2 * LO; float pf[NV + 1]; pf[0] = 0.f; float own[16]; \
                    _Pragma("unroll") for (int i = 0; i < NV; ++i) { const int q = pos0 - LO + i; const bool ok = (q >= 0) && (q < L); \
                        const float v = ok ? bf2f(PB[(size_t)(m0 - LO + i) * 256 + (g) * 64 + lane]) : 0.f; if (i >= LO && i < LO + 16) own[i - LO] = v; pf[i + 1] = v; } \
                    _Pragma("unroll") for (int i = 0; i < NV; ++i) pf[i + 1] += pf[i]; \
                    LDS_WAIT(); \
                    _Pragma("unroll") for (int k = 0; k < 16; ++k) { const int p = pos0 + k; const int st = max(p - LO, 0), en = min(p + LO, L); yb[k * 72 + lane] = (bf16)f2bf((pf[k + 2 * LO] - pf[k]) * __builtin_amdgcn_rcpf((float)(en - st)) - own[k]); } \
                    LDS_WAIT(); asm volatile("" ::: "memory"); \
                    const bf16x8 a0 = *(const LAS bf16x8*)(yb + (lane & 15) * 72 + 8 * (lane >> 4)), a1 = *(const LAS bf16x8*)(yb + (lane & 15) * 72 + 32 + 8 * (lane >> 4)); \
                    _Pragma("unroll") for (int nb = 0; nb < 4; ++nb) { f32x4 d = {0.f, 0.f, 0.f, 0.f};         \
                        d = __builtin_amdgcn_mfma_f32_16x16x32_bf16(a0, wfr[0][nb], d, 0, 0, 0); d = __builtin_amdgcn_mfma_f32_16x16x32_bf16(a1, wfr[1][nb], d, 0, 0, 0); \
                        _Pragma("unroll") for (int r = 0; r < 4; ++r) MIX0[(size_t)(m0 + 4 * (lane >> 4) + r) * DM + 768 + (g) * 64 + 16 * nb + (lane & 15)] = (bf16)f2bf(d[r] * ps4[nb]); } } } }
            POOL_G(0) POOL_G(1) POOL_G(2) POOL_G(3)
#undef POOL_G
            __syncthreads();
        }
        {
            float refB;
            { float mq = fabsf(PRM(P_QG)[lane]), mk = fabsf(PRM(P_KG)[lane]);
#pragma unroll
              for (int o = 1; o < 64; o <<= 1) { mq = fmaxf(mq, shx(mq, o)); mk = fmaxf(mk, shx(mk, o)); }
              refB = __uint_as_float((unsigned)__builtin_amdgcn_readfirstlane((int)__float_as_uint(SC64 * 64.0f * mq * mk * 1.14f))); }
            const bool fixref = refB < 40.0f;
#define GQA_UNIT(FIX_, m0_, h_, b_, kvh_, NT_) att64q8::attn_unit<8, 768, 64, 256, DM, FIX_>((const unsigned char*)Q0 + (size_t)(m0_) * 768 + (h_) * 64, (const unsigned char*)K0 + (size_t)((b_) * 4 + (kvh_)) * NKEY * 64, V0T8 + (size_t)((b_) * 4 + (kvh_)) * (NKEY / 64) * 4096, \
                                                  MIX0 + (size_t)(m0_) * DM + (h_) * 64, (NT_), (char*)lds_raw, wave, refB)
            for (int rep = 0; rep < REP_A0; ++rep)
            for (int i = 0; i < 6; ++i) {
                const int grp = vcu >> 5, b = grp >> 2, kvh = grp & 3; const int local = i * 32 + (vcu & 31); const int gq = local >> 6, qb = local & 63; const int h = kvh * 3 + gq;
                bool redo = !fixref;
                if (fixref) { const bool sunk = GQA_UNIT(1, b * SEQ + qb * 256, h, b, kvh, NKEY / 64); redo = WG_ANY(sunk); }
                if (redo) (void)GQA_UNIT(0, b * SEQ + qb * 256, h, b, kvh, NKEY / 64);
            }
            if (vcu < 24) { const int b = vcu / 12, h = vcu % 12, kvh = h / 3;
                bool redo = !fixref;
                if (fixref) { const bool sunk = GQA_UNIT(1, MS + b * CTX, h, b, kvh, CTX / 64); redo = WG_ANY(sunk); }
                if (redo) (void)GQA_UNIT(0, MS + b * CTX, h, b, kvh, CTX / 64); }
#undef GQA_UNIT
        }
    }
    SEAM(4);

    if (IN(5)) { const int lane = lane_id(); const int tid = wave * 64 + lane; (void)tid;
        pg8::Gemm g{MIX0, W0OUT, DM, DM, 0, 0, 0}; pg8::StaticOrder S; S.init(MA / 256, DM / 256, G, bx);
        pg8::EpiPlain E{Y0, DM};
        for (int rep = 0; rep < REP_G; ++rep) pg8::gemm_phase(lds, g, S, E, wave);
    }
    SEAM(5);

    if (IN(6)) { const int lane = lane_id(); const int tid = wave * 64 + lane; (void)tid;
        const Row16 LG = ld_row_f32(PRM(P_LN1G), lane), LB = ld_row_f32(PRM(P_LN1B), lane);
        Row16 GT, SH, SC; int vcur = -1;
#define P6_LD(m_) ld_rowin(((m_) < MS) ? x_in + (size_t)(m_) * DM : ctx_in + (size_t)((m_) - MS) * DM, Y0 + (size_t)(m_) * DM, lane)
        int m = gw; RowIn q0 = P6_LD(m), q1, q2;
        { const int m1 = m + NGW, m2 = m + 2 * NGW; if (m1 < MA) q1 = P6_LD(m1); if (m2 < MA) q2 = P6_LD(m2); }
        for (; m < MA; m += NGW) {
            const RowIn cur = q0; q0 = q1; q1 = q2; const int m3 = m + 3 * NGW;
            if (m3 < MA) q2 = P6_LD(m3);
            const int v = (m < MS) ? (m >> 14) : 2;
            if (v != vcur) { const float* md = mods + (size_t)(0 * 3 + v) * 6144; GT = ld_row_f32(md + 2 * 1024, lane); SH = ld_row_f32(md + 3 * 1024, lane); SC = ld_row_f32(md + 4 * 1024, lane); vcur = v; }
            Row16 z;
#pragma unroll
            for (int j = 0; j < 4; ++j) z.v[j] = cur.x[j] * ALPHA + GT.v[j] * bf4(cur.y[j]);
            ln_row2(z, LG, LB);
            st_row_f32((m < MS) ? out + (size_t)m * DM : x1c + (size_t)(m - MS) * DM, lane, z);
#pragma unroll
            for (int j = 0; j < 4; ++j) z.v[j] = z.v[j] * (1.0f + SC.v[j]) + SH.v[j];
            st_row_i8(H18 + (size_t)m * DM, SA_ROW + m, lane, z);
        }
#undef P6_LD
    }
    SEAM(6);

    if (IN(7)) { const int lane = lane_id(); const int tid = wave * 64 + lane; (void)tid;
        pg8::Gemm g{H18, W0GU8, DM, DM, 0, SA_ROW, SW_0GU, 0}; pg8::StaticOrder S; S.init(MA / 256, 2 * FF0 / 256, G, bx);
        pg8::EpiSwiglu8 E{ACT08, FF0, 1.0f};
        for (int rep = 0; rep < REP_G; ++rep) pg8::gemm_phase<pg8::EpiSwiglu8, pg8::StaticOrder, 2>(lds, g, S, E, wave);
    }
    SEAM(7);

    if (IN(8)) { const int lane = lane_id(); const int tid = wave * 64 + lane; (void)tid;
        pg8::Gemm g{ACT08, W0D8, FF0, FF0, 0, 0, 0}; pg8::StaticOrder S; S.init(MA / 256, DM / 256, G, bx);
        pg8::EpiPlainS E{Y0B, DM, 1.0f / 1024.0f};
        for (int rep = 0; rep < REP_G; ++rep) pg8::gemm_phase<pg8::EpiPlainS, pg8::StaticOrder, true>(lds, g, S, E, wave);
    }
    SEAM(8);

    if (IN(9)) { const int lane = lane_id(); const int tid = wave * 64 + lane; (void)tid;
        const Row16 LG = ld_row_f32(PRM(P_LN2G), lane), LB = ld_row_f32(PRM(P_LN2B), lane);
        Row16 GT, SH, SC; int vcur = -1;
#define P9_LD(m_) ld_rowin(((m_) < MS) ? out + (size_t)(m_) * DM : x1c + (size_t)((m_) - MS) * DM, Y0B + (size_t)(m_) * DM, lane)
        int m = gw; RowIn q0 = P9_LD(m), q1, q2;
        { const int m1 = m + NGW, m2 = m + 2 * NGW; if (m1 < MA) q1 = P9_LD(m1); if (m2 < MA) q2 = P9_LD(m2); }
        for (; m < MA; m += NGW) {
            const RowIn cur = q0; q0 = q1; q1 = q2; const int m3 = m + 3 * NGW;
            if (m3 < MA) q2 = P9_LD(m3);
            const int v = (m < MS) ? (m >> 14) : 2;
            if (v != vcur) { const float* md0 = mods + (size_t)(0 * 3 + v) * 6144; const float* md1 = mods + (size_t)(1 * 3 + v) * 6144;
                GT = ld_row_f32(md0 + 5 * 1024, lane); SH = ld_row_f32(md1, lane); SC = ld_row_f32(md1 + 1024, lane); vcur = v; }
            Row16 z;
#pragma unroll
            for (int j = 0; j < 4; ++j) z.v[j] = cur.x[j] * ALPHA + GT.v[j] * bf4(cur.y[j]);
            ln_row2(z, LG, LB);
            if (m < MS) st_row_f32(out + (size_t)m * DM, lane, z);
#pragma unroll
            for (int j = 0; j < 4; ++j) z.v[j] = z.v[j] * (1.0f + SC.v[j]) + SH.v[j];
            st_row_i8(U18 + (size_t)m * DM, SA_ROW + m, lane, z);
        }
#undef P9_LD
    }
    SEAM(9);

    if (IN(10)) { const int lane = lane_id(); const int tid = wave * 64 + lane; (void)tid;
        pg8::Gemm g{U18, W1IN8, DM, DM, 0, SA_ROW, SW_1IN, 0}; pg8::StaticOrder S; S.init(MA / 256, N_IN1 / 256, G, bx);
        pg8::EpiPlain E{H1RAW, N_IN1};
        for (int rep = 0; rep < REP_G; ++rep) pg8::gemm_phase<pg8::EpiPlain, pg8::StaticOrder, 2>(lds, g, S, E, wave);
    }
    SEAM(10);

    if (IN(11)) { const int lane = lane_id(); const int tid = wave * 64 + lane; (void)tid;
        const float* gq = PRM(P_QLG); const float* gk = PRM(P_KVLG);
        for (int m = gw; m < MA; m += NGW) {
            bf16* hrow = H1RAW + (size_t)m * N_IN1;
            {
                unsigned w[3]; float a[6]; float ssq = 0.f;
#pragma unroll
                for (int j = 0; j < 3; ++j) { w[j] = *(const unsigned*)(hrow + C1_CQ + j * 128 + lane * 2); a[2 * j] = __uint_as_float(w[j] << 16); a[2 * j + 1] = __uint_as_float(w[j] & 0xffff0000u); ssq += a[2 * j] * a[2 * j] + a[2 * j + 1] * a[2 * j + 1]; }
                const float rstd = 1.0f / sqrtf(wave_sum(ssq) * (1.f / 384.f) + EPS);
#pragma unroll
                for (int j = 0; j < 3; ++j) { const int k = j * 128 + lane * 2; *(unsigned*)(hrow + C1_CQ + k) = pk2(a[2 * j] * rstd * gq[k], a[2 * j + 1] * rstd * gq[k + 1]); }
            }
            {
                unsigned w[2]; float a[4]; float ssq = 0.f;
#pragma unroll
                for (int j = 0; j < 2; ++j) { w[j] = *(const unsigned*)(hrow + C1_CKV + j * 128 + lane * 2); a[2 * j] = __uint_as_float(w[j] << 16); a[2 * j + 1] = __uint_as_float(w[j] & 0xffff0000u); ssq += a[2 * j] * a[2 * j] + a[2 * j + 1] * a[2 * j + 1]; }
                const float rstd = 1.0f / sqrtf(wave_sum(ssq) * (1.f / 256.f) + EPS);
#pragma unroll
                for (int j = 0; j < 2; ++j) { const int k = j * 128 + lane * 2; *(unsigned*)(hrow + C1_CKV + k) = pk2(a[2 * j] * rstd * gk[k], a[2 * j + 1] * rstd * gk[k + 1]); }
            }
            {
                const bool isseq = m < MS; const int t = m & (SEQ - 1); const int pr = t >> 6, pc = t & 63; const int i = lane & 31;
                float v = bf2f(hrow[C1_KR + i]);
                const int pos = (i & 16) ? pc : pr; const int fi = i & 7; const bool first = (i & 8) == 0;
                const float cs = isseq ? cos8[pos * 8 + fi] : 1.f, sn = isseq ? sin8[pos * 8 + fi] : 0.f;
                const float pv = shx(v, 8);
                const float o = first ? v * cs - pv * sn : pv * sn + v * cs;
                const unsigned char ob = (unsigned char)(__builtin_amdgcn_cvt_pk_fp8_f32(o, 0.f, 0, false) & 0xff); const int kr = kvrow(m);
                if (lane < 32) {
#pragma unroll
                    for (int h = 0; h < 8; ++h) { K1B[k1off(kr, h) + 64 + i] = ob; K1B[k1off(kr, h) + 96 + i] = 0; } }
            }
        }
    }
    SEAM(11);

    if (IN(12)) { const int lane = lane_id(); const int tid = wave * 64 + lane; (void)tid;
        { pg8::Gemm g{H1RAW + C1_CQ, WQ, 384, N_IN1, 0, 0, 0}; pg8::StaticOrder S; S.init(MS / 256, 768 / 256, G, bx);
          pg8::EpiPlain E{Q1, 768};
          for (int rep = 0; rep < REP_G; ++rep) pg8::gemm_phase(lds, g, S, E, wave); }
        { pg8::Gemm g{H1RAW + C1_CKV, WKV, 256, N_IN1, 0, 0, 0}; pg8::StaticOrder S; S.init(MA / 256, 1024 / 256, G, G - 1 - bx);
          pg8::EpiKV E{K1B, V1};
          for (int rep = 0; rep < REP_G; ++rep) pg8::gemm_phase(lds, g, S, E, wave); }
    }
    SEAM(12);

    if (IN(13)) { const int lane = lane_id(); const int tid = wave * 64 + lane; (void)tid;
        build_vt_images(V1, 512, 8, V1T8, gw, NGW, (LAS unsigned char*)lds + 4096 + wave * 4096, lane);
        __syncthreads();
        {
            float mx0 = 0.f, mx1 = 0.f;
            for (int r = gw; r < 2 * NKEY; r += NGW) {
                const u32x4 kb = *(const u32x4*)(K1B + k1off(r, lane >> 3) + (lane & 7) * 16); float q2 = 0.f;
#pragma unroll
                for (int c = 0; c < 4; ++c) { const int w_ = (int)kb[c]; const float a0 = __builtin_amdgcn_cvt_f32_fp8(w_, 0), a1 = __builtin_amdgcn_cvt_f32_fp8(w_, 1), a2 = __builtin_amdgcn_cvt_f32_fp8(w_, 2), a3 = __builtin_amdgcn_cvt_f32_fp8(w_, 3);
                    q2 += (a0 * a0 + a1 * a1) + (a2 * a2 + a3 * a3); }
                q2 += shx(q2, 1); q2 += shx(q2, 2); q2 += shx(q2, 4);
                if (r < NKEY) mx0 = fmaxf(mx0, q2); else mx1 = fmaxf(mx1, q2);
            }
            LAS float* km = (LAS float*)lds;
            if ((lane & 7) == 0) { km[wave * 16 + (lane >> 3)] = mx0; km[wave * 16 + 8 + (lane >> 3)] = mx1; }
            __syncthreads();
            if (tid < 16) { float m_ = 0.f;
#pragma unroll
                for (int w = 0; w < 8; ++w) m_ = fmaxf(m_, km[w * 16 + tid]);
                __hip_atomic_fetch_max((unsigned*)(ctl + CW_KMAX) + tid, __float_as_uint(m_), __ATOMIC_RELAXED, __HIP_MEMORY_SCOPE_AGENT); }
            __syncthreads();
        }
        for (int m = gw; m < MS; m += NGW) {
            const int t = m & (SEQ - 1); const int pr = t >> 6, pc = t & 63;
            const int h = lane >> 3, w = lane & 7; const bf16* qh = Q1 + (size_t)m * 768 + h * 96; unsigned char* dq = Q1B + (size_t)m * 1024 + h * 128;
            const u32x4 nraw = *(const u32x4*)(qh + 8 * w); const u32x2 raw = *(const u32x2*)(qh + 64 + 4 * w);
            {   const f32x4 n0 = bf4((u32x2){nraw.x, nraw.y}) * 8.0f, n1 = bf4((u32x2){nraw.z, nraw.w}) * 8.0f;
                int w0 = 0, w1 = 0; w0 = __builtin_amdgcn_cvt_pk_fp8_f32(n0[0], n0[1], w0, false); w0 = __builtin_amdgcn_cvt_pk_fp8_f32(n0[2], n0[3], w0, true);
                w1 = __builtin_amdgcn_cvt_pk_fp8_f32(n1[0], n1[1], w1, false); w1 = __builtin_amdgcn_cvt_pk_fp8_f32(n1[2], n1[3], w1, true);
                u32x2 wv; wv.x = (unsigned)w0; wv.y = (unsigned)w1; *(u32x2*)(dq + 8 * w) = wv; }
            float v[4] = {__uint_as_float(raw.x << 16), __uint_as_float(raw.x & 0xffff0000u), __uint_as_float(raw.y << 16), __uint_as_float(raw.y & 0xffff0000u)};
            const int pos = (w & 4) ? pc : pr; const bool first = (w & 2) == 0; float o[4];
#pragma unroll
            for (int j = 0; j < 4; ++j) { const int fi = 4 * (w & 1) + j; const float cs = cos8[pos * 8 + fi], sn = sin8[pos * 8 + fi]; const float pv = shx(v[j], 2);
                o[j] = (first ? v[j] * cs - pv * sn : pv * sn + v[j] * cs) * 8.0f; }
            int wr_ = 0; wr_ = __builtin_amdgcn_cvt_pk_fp8_f32(o[0], o[1], wr_, false); wr_ = __builtin_amdgcn_cvt_pk_fp8_f32(o[2], o[3], wr_, true);
            *(int*)(dq + 64 + 4 * w) = wr_; *(int*)(dq + 96 + 4 * w) = 0;
        }
    }
    SEAM(13);

    if (IN(14)) { const int lane = lane_id(); const int tid = wave * 64 + lane; (void)tid;
        const int grp = vcu >> 4, b = grp >> 3, h = grp & 7;
        {   const att::NoMask nm;
            for (int rep = 0; rep < REP_A1; ++rep)
            for (int i = 0; i < 4; ++i) {
                int b_ = b, h_ = h; asm volatile("" : "+s"(b_), "+s"(h_));
                const float kmax_ = sqrtf(__uint_as_float(__hip_atomic_load((unsigned*)(ctl + CW_KMAX) + b_ * 8 + h_, RLX_AGENT)));
                const int qb = i * 16 + (vcu & 15); const int m0 = b_ * SEQ + qb * 256;
#pragma unroll 1
                for (int pass = 0; pass < 2; ++pass) {
                    const bool sunk = att96q8::attn_unit<8, 1024, 128, 512, DM>(Q1B + (size_t)m0 * 1024 + h_ * 128, K1B + (size_t)(b_ * 8 + h_) * NKEY * 128, V1T8 + (size_t)(b_ * 8 + h_) * (NKEY / 64) * 4096,
                                                        MIX1 + (size_t)m0 * DM + h_ * 64, NKEY / 64, (char*)lds_raw, wave, kmax_, pass == 0);
                    if (!WG_ANY(sunk)) break; }
            }
        }
        {
            const int lane = lane_id(); const int tid = wave * 64 + lane;
            LAS float* bl = (LAS float*)(lds + att::L_BIAS);
            for (int i = tid; i < 64 + 465 + 64; i += 512) bl[i] = (i >= 64 && i < 64 + 465) ? PRM(P_NAB)[h * 465 + i - 64] * LOG2E : 0.f;
            __syncthreads();
            for (int rep = 0; rep < REP_NA; ++rep)
            for (int i = 0; i < 4; ++i) {
                const int rb = i * 16 + (vcu & 15); const int r0 = rb * 4, r = r0 + (wave >> 1);
                att::NaMask mk; mk.ctx_row0 = MS + b * CTX; mk.seq_row0 = (long)b * SEQ; mk.kr0 = min(max(r0 - 4, 0), 248);
                mk.r = r; mk.rs = min(max(r - 4, 0), 248); mk.j = (wave & 1) * 32 + (lane & 31); mk.cs = min(max(mk.j - 8, 0), 48); mk.bias = bl + 64;
                const int klast = min(max(r0 + 3 - 4, 0), 248) + 7; const int NT = 4 + (klast - mk.kr0 + 1);
                const int m0 = b * SEQ + rb * 256 + wave * 32;
                att::attn_unit<64>(H1RAW + (size_t)m0 * N_IN1 + C1_NQ + h * 64, N_IN1, H1RAW + C1_NK + h * 64, N_IN1, H1RAW + C1_NV + h * 64, N_IN1,
                                   MIX1 + (size_t)m0 * DM + 512 + h * 64, DM, NT, mk, lds, wave);
            }
        }
    }
    SEAM(14);

    if (IN(15)) { const int lane = lane_id(); const int tid = wave * 64 + lane; (void)tid;
#define MOE_CVT() do { \
        LAS float* scr = (LAS float*)(lds + wave * 16384); \
        {   constexpr int IG = 16 * (2 * FFE / 32), ID = (FFE / 64) * 32, IE = IG + ID; \
            for (int it = gw; it < NEXP * IE; it += NGW) { \
                const int e = it / IE; int r = it % IE; \
                if (r < IG) { const int nbk = 2 * FFE / 32, kb = r / nbk, nb = r % nbk; const int j0 = 32 * nb, pn = j0 >> 8, half = (j0 >> 7) & 1, i = j0 & 127; \
                    cvt_item8((half ? args.in[I_ODWU] : args.in[I_ODWG]) + (size_t)e * DM * FFE, FFE, 128 * pn + i, 64 * kb, W8GU + (size_t)e * 2 * FFE * DM, DM, j0, 32.f, scr, lane); } \
                else { r -= IG; const int kb = r / 32, nb = r % 32; cvt_item8(args.in[I_ODWD] + (size_t)e * FFE * DM, DM, 32 * nb, 64 * kb, W8D + (size_t)e * DM * FFE, FFE, 32 * nb, 128.f, scr, lane); } \
            } \
        } \
     \
        } while (0)
        if (vcu & 1) { MOE_CVT(); __syncthreads(); }
        { pg8::Gemm g{MIX1, W1OUT, DM, DM, 0, 0, 0}; pg8::StaticOrder S; S.init(MS / 256, DM / 256, G, bx);
          pg8::EpiPlain E{Y1, DM};
          for (int rep = 0; rep < REP_G; ++rep) pg8::gemm_phase(lds, g, S, E, wave); }
        if (!(vcu & 1)) MOE_CVT();
#undef MOE_CVT
    }
    SEAM(15);

    if (IN(16)) { const int lane = lane_id(); const int tid = wave * 64 + lane; (void)tid;
        const float* br_ = PRM(P_BR);
        LAS float* wl = (LAS float*)(lds + 1024);
        for (int i = tid; i < 8192; i += 512) wl[(i & 7) * 1024 + (i >> 3)] = PRM(P_WR)[i];
        __syncthreads();
        const Row16 LG = ld_row_f32(PRM(P_LN1G) + DM, lane), LB = ld_row_f32(PRM(P_LN1B) + DM, lane);
        int cnt[8];
#pragma unroll
        for (int e = 0; e < 8; ++e) cnt[e] = 0;
        const int mbeg = gw * 16; const int v = mbeg >> 14; const float* md = mods + (size_t)(1 * 3 + v) * 6144;
        const Row16 GT = ld_row_f32(md + 2 * 1024, lane), SH = ld_row_f32(md + 3 * 1024, lane), SC = ld_row_f32(md + 4 * 1024, lane);
#define P16_LD(m_) ld_rowin(out + (size_t)(m_) * DM, Y1 + (size_t)(m_) * DM, lane)
        RowIn q0 = P16_LD(mbeg), q1 = P16_LD(mbeg + 1), q2 = P16_LD(mbeg + 2);
        for (int m = mbeg; m < mbeg + 16; ++m) {
            const RowIn cur = q0; q0 = q1; q1 = q2;
            if (m + 3 < mbeg + 16) q2 = P16_LD(m + 3);
            Row16 z;
#pragma unroll
            for (int j = 0; j < 4; ++j) z.v[j] = cur.x[j] * ALPHA + GT.v[j] * bf4(cur.y[j]);
            ln_row2(z, LG, LB);
            st_row_f32(out + (size_t)m * DM, lane, z);
#pragma unroll
            for (int j = 0; j < 4; ++j) z.v[j] = z.v[j] * (1.0f + SC.v[j]) + SH.v[j];
            { unsigned* hp = (unsigned*)(H3B + (size_t)m * 1024) + lane;
#pragma unroll
              for (int j = 0; j < 4; ++j) { int w_ = 0; w_ = __builtin_amdgcn_cvt_pk_fp8_f32(z.v[j][0] * 4.0f, z.v[j][1] * 4.0f, w_, false); w_ = __builtin_amdgcn_cvt_pk_fp8_f32(z.v[j][2] * 4.0f, z.v[j][3] * 4.0f, w_, true); hp[64 * j] = (unsigned)w_; } }
            float lg[8];
#pragma unroll
            for (int e = 0; e < 8; ++e) { float a = 0.f;
#pragma unroll
                for (int j = 0; j < 4; ++j) { const f32x4 w = *(const LAS f32x4*)(wl + e * 1024 + 256 * j + 4 * lane); a += (z.v[j][0] * w[0] + z.v[j][1] * w[1]) + (z.v[j][2] * w[2] + z.v[j][3] * w[3]); }
                lg[e] = a; __builtin_amdgcn_sched_barrier(0); }
            {
                const bool b0 = lane & 1, b1 = lane & 2, b2 = lane & 4;
                float t4[4], t2[2], t1;
#pragma unroll
                for (int i = 0; i < 4; ++i) { const float keep = b0 ? lg[4 + i] : lg[i], send = b0 ? lg[i] : lg[4 + i]; t4[i] = keep + shx(send, 1); }
#pragma unroll
                for (int i = 0; i < 2; ++i) { const float keep = b1 ? t4[2 + i] : t4[i], send = b1 ? t4[i] : t4[2 + i]; t2[i] = keep + shx(send, 2); }
                { const float keep = b2 ? t2[1] : t2[0], send = b2 ? t2[0] : t2[1]; t1 = keep + shx(send, 4); }
                t1 += shx(t1, 8); t1 += shx(t1, 16); t1 += shx(t1, 32);
#pragma unroll
                for (int e = 0; e < 8; ++e) lg[e] = __uint_as_float((unsigned)__builtin_amdgcn_readlane((int)__float_as_uint(t1), (e >> 2) + 2 * ((e >> 1) & 1) + 4 * (e & 1))) + br_[e];
            }
            int e0 = 0; float v0 = lg[0];
#pragma unroll
            for (int e = 1; e < 8; ++e) if (lg[e] > v0) { v0 = lg[e]; e0 = e; }
            int e1 = -1; float v1 = -INFINITY;
#pragma unroll
            for (int e = 0; e < 8; ++e) if (e != e0 && lg[e] > v1) { v1 = lg[e]; e1 = e; }
            const float g0 = 1.0f / (1.0f + __expf(v1 - v0)), g1 = 1.0f - g0;
            if (lane == 0) { r_exp[2 * m] = e0; r_exp[2 * m + 1] = e1; r_gate[2 * m] = g0; r_gate[2 * m + 1] = g1; }
#pragma unroll
            for (int e = 0; e < 8; ++e) cnt[e] += (e == e0) + (e == e1);
        }
        {
            LAS int* wc = (LAS int*)lds;
            if (lane == 0) {
#pragma unroll
                for (int e = 0; e < 8; ++e) wc[wave * 8 + e] = cnt[e]; }
            __syncthreads();
            if (tid < 8) { int t = 0;
#pragma unroll
                for (int w = 0; w < 8; ++w) t += wc[w * 8 + tid];
                wgcnt[vcu * 8 + tid] = t; }
            __syncthreads();
        }
    }
    SEAM(16);

    int ecnt0 = 0, ecnt1 = 0, ecnt2 = 0, ecnt3 = 0, ecnt4 = 0, ecnt5 = 0, ecnt6 = 0, ecnt7 = 0, epre0 = 0, epre1 = 0, epre2 = 0, epre3 = 0, epre4 = 0, epre5 = 0, epre6 = 0, epre7 = 0;
    int ets0 = 0, ets1 = 0, ets2 = 0, ets3 = 0, ets4 = 0, ets5 = 0, ets6 = 0, ets7 = 0, ets8 = 0;
#define FOR_E(X) X(0, 1) X(1, 2) X(2, 3) X(3, 4) X(4, 5) X(5, 6) X(6, 7) X(7, 8)
    if (hi > 17) {
        LAS int* red = (LAS int*)lds;
        const int tid_ = wave * 64 + lane_id();
        if (tid_ < 16) red[tid_] = 0;
        __syncthreads();
        { const int wg = tid_ >> 1, hf = tid_ & 1; const int* c = wgcnt + wg * 8 + hf * 4; const bool ahead = wg < vcu;
#pragma unroll
            for (int j = 0; j < 4; ++j) { const int cv = c[j]; __hip_atomic_fetch_add(red + hf * 4 + j, cv, __ATOMIC_RELAXED, __HIP_MEMORY_SCOPE_WORKGROUP);
                if (ahead) __hip_atomic_fetch_add(red + 8 + hf * 4 + j, cv, __ATOMIC_RELAXED, __HIP_MEMORY_SCOPE_WORKGROUP); } }
        __syncthreads();
#define X_(E_, N_) ecnt##E_ = red[E_]; epre##E_ = red[8 + E_]; ets##N_ = ets##E_ + (ecnt##E_ + 255) / 256;
        FOR_E(X_)
#undef X_
        if (tid_ == 0) { MISC[16] = (unsigned)ets1; MISC[17] = (unsigned)ets2; MISC[18] = (unsigned)ets3; MISC[19] = (unsigned)ets4; MISC[20] = (unsigned)ets5; MISC[21] = (unsigned)ets6; MISC[22] = (unsigned)ets7; MISC[23] = (unsigned)ets8; }
        __syncthreads();
    }

    if (IN(17)) { const int lane = lane_id(); const int tid = wave * 64 + lane; (void)tid;
        {   const int blk = gw;
            const bool actl = lane < 16; const int m = blk * 16 + (lane & 15);
            const int e0 = actl ? r_exp[2 * m] : -1, e1 = actl ? r_exp[2 * m + 1] : -1;
            LAS int* wc = (LAS int*)lds;
            unsigned long long b0m[8], b1m[8];
#pragma unroll
            for (int e = 0; e < 8; ++e) { b0m[e] = __ballot(e0 == e); b1m[e] = __ballot(e1 == e); }
            if (lane == 0) {
#pragma unroll
                for (int e = 0; e < 8; ++e) wc[wave * 8 + e] = __popcll(b0m[e]) + __popcll(b1m[e]); }
            __syncthreads();
            int d0 = 0, d1 = 0; const unsigned long long below = (1ull << lane) - 1ull;
#define X_(E_, N_) { int base = ets##E_ * 256 + epre##E_; for (int w = 0; w < wave; ++w) base += wc[w * 8 + E_]; const int c0 = __popcll(b0m[E_]); \
                if (e0 == E_) d0 = base + __popcll(b0m[E_] & below); if (e1 == E_) d1 = base + c0 + __popcll(b1m[E_] & below); }
            FOR_E(X_)
#undef X_
            if (actl) { r_dest[2 * m] = d0; r_dest[2 * m + 1] = d1; }
#pragma unroll
            for (int i = 0; i < 16; ++i) {
                const int dd0 = __builtin_amdgcn_readlane(d0, i), dd1 = __builtin_amdgcn_readlane(d1, i);
                const u32x4 a = *((const u32x4*)(H3B + (size_t)(blk * 16 + i) * 1024) + lane);
                *((u32x4*)(XPAD8 + (size_t)dd0 * 1024) + lane) = a; *((u32x4*)(XPAD8 + (size_t)dd1 * 1024) + lane) = a;
            }
            __syncthreads();
        }
        if (bx < 8) { int r0 = 0, r1 = 0;
#define X_(E_, N_) if (bx == E_) { r0 = ets##E_ * 256 + ecnt##E_; r1 = ets##N_ * 256; }
            FOR_E(X_)
#undef X_
            const u32x4 z = (u32x4){0u, 0u, 0u, 0u};
            for (int r = r0 + wave; r < r1; r += 8) *((u32x4*)(XPAD8 + (size_t)r * 1024) + lane) = z; }
    }
    SEAM(17);


#define MT_(k_) __builtin_amdgcn_readfirstlane((int)MISC[16 + (k_)])
#define MOE_ORDER(S_, c_, nN_) pg8::MoeOrder S_; { const int t0_ = (c_) * MOE_CHUNK_TILES; int nm_ = MT_(7) - t0_; { const int cap_ = ((c_) == MOE_CHUNKS - 1) ? MOE_TILES - t0_ : MOE_CHUNK_TILES; nm_ = nm_ < 0 ? 0 : (nm_ > cap_ ? cap_ : nm_); } \
        S_.S.init(nm_, (nN_), G, bx); S_.tile0 = t0_; S_.ts1 = MT_(0); S_.ts2 = MT_(1); S_.ts3 = MT_(2); S_.ts4 = MT_(3); S_.ts5 = MT_(4); S_.ts6 = MT_(5); S_.ts7 = MT_(6); }
#define MOE_UP(ph, c_) if (IN(ph)) { MOE_ORDER(S, c_, 2 * FFE / 256); pg8::Gemm g{XPAD8 + (size_t)(c_) * MOE_CHUNK_TILES * 256 * DM, W8GU, DM, DM, (size_t)2 * FFE * DM, nullptr, nullptr, 0}; \
        pg8::EpiSwiglu8F E{ACT8, FFE, 1.0f / 128.0f}; for (int rep = 0; rep < REP_UP; ++rep) pg8::gemm_phase<pg8::EpiSwiglu8F, pg8::MoeOrder, true>(lds, g, S, E, wave); } SEAM(ph);
#define MOE_DOWN(ph, c_) if (IN(ph)) { MOE_ORDER(S, c_, DM / 256); pg8::Gemm g{ACT8, W8D, FFE, FFE, (size_t)DM * FFE, nullptr, nullptr, 0}; \
        pg8::EpiPlainS E{YPAD + (size_t)(c_) * MOE_CHUNK_TILES * 256 * DM, DM, 1.0f / 1024.0f}; for (int rep = 0; rep < REP_DOWN; ++rep) pg8::gemm_phase<pg8::EpiPlainS, pg8::MoeOrder, true>(lds, g, S, E, wave); } SEAM(ph);
    MOE_UP(19, 0) MOE_DOWN(20, 0) MOE_UP(21, 1) MOE_DOWN(22, 1)
    static_assert(MOE_CHUNKS == 2 && MOE_TILES - MOE_CHUNK_TILES >= MOE_CHUNK_TILES, "chunk phases");

    if (IN(29)) { const int lane = lane_id(); const int tid = wave * 64 + lane; (void)tid;
        const Row16 LG = ld_row_f32(PRM(P_LN2G) + DM, lane), LB = ld_row_f32(PRM(P_LN2B) + DM, lane);
        Row16 GT; int vcur = -1;
        struct RowG { f32x4 x[4]; u32x2 ya[4], yb[4]; float g0, g1; };
#define P29_LDD(m_, D0, D1, G0, G1) do { D0 = r_dest[2 * (m_)]; D1 = r_dest[2 * (m_) + 1]; G0 = r_gate[2 * (m_)]; G1 = r_gate[2 * (m_) + 1]; } while (0)
#define P29_LDR(Q, m_, D0, D1, G0, G1) do { const f32x4* q_ = (const f32x4*)(out + (size_t)(m_) * DM) + lane; const u32x2* a_ = (const u32x2*)(YPAD + (size_t)(D0) * DM) + lane; const u32x2* b_ = (const u32x2*)(YPAD + (size_t)(D1) * DM) + lane; \
            _Pragma("unroll") for (int j = 0; j < 4; ++j) { Q.x[j] = q_[64 * j]; Q.ya[j] = a_[64 * j]; Q.yb[j] = b_[64 * j]; } Q.g0 = G0; Q.g1 = G1; } while (0)
        int m = gw; RowG q0, q1, q2; int dn0 = 0, dn1 = 0; float gn0 = 0.f, gn1 = 0.f;
        {   int d0, d1; float g0, g1;
            P29_LDD(m, d0, d1, g0, g1); P29_LDR(q0, m, d0, d1, g0, g1);
            P29_LDD(m + NGW, d0, d1, g0, g1); P29_LDR(q1, m + NGW, d0, d1, g0, g1);
            P29_LDD(m + 2 * NGW, d0, d1, g0, g1); P29_LDR(q2, m + 2 * NGW, d0, d1, g0, g1);
            P29_LDD(m + 3 * NGW, dn0, dn1, gn0, gn1); }
        for (; m < MS; m += NGW) {
            const RowG cur = q0; q0 = q1; q1 = q2; const int m3 = m + 3 * NGW, m4 = m + 4 * NGW;
            int de0 = 0, de1 = 0; float ge0 = 0.f, ge1 = 0.f;
            if (m4 < MS) P29_LDD(m4, de0, de1, ge0, ge1);
            if (m3 < MS) P29_LDR(q2, m3, dn0, dn1, gn0, gn1);
            dn0 = de0; dn1 = de1; gn0 = ge0; gn1 = ge1;
            const int v = m >> 14;
            if (v != vcur) { GT = ld_row_f32(mods + (size_t)(1 * 3 + v) * 6144 + 5 * 1024, lane); vcur = v; }
            Row16 z;
#pragma unroll
            for (int j = 0; j < 4; ++j) z.v[j] = cur.x[j] * ALPHA + GT.v[j] * (cur.g0 * bf4(cur.ya[j]) + cur.g1 * bf4(cur.yb[j]));
            ln_row2(z, LG, LB);
            st_row_f32(out + (size_t)m * DM, lane, z);
        }
#undef P29_LDD
#undef P29_LDR
    }
#undef IN
#undef SEAM
#undef G
#undef bx
#undef vcu
#undef gw
#undef NGW
#undef PRM
#undef out
#undef x_in
#undef ctx_in
#undef mods
}

extern "C" void kernel_launch(void* const* d_in, const int* in_sizes, int n_in, void* d_out, int out_size, void* d_ws, size_t ws_size, hipStream_t stream) {
    static int grid = 0;
    if (grid == 0) {
        if (n_in != N_INPUTS || ws_size < WS_END) { fprintf(stderr, "kernel_launch: unexpected n_in %d / ws %zu\n", n_in, ws_size); grid = -1; return; }
        int dev = 0, cus = 0, per_cu = 0;
        if (hipGetDevice(&dev) != hipSuccess || hipDeviceGetAttribute(&cus, hipDeviceAttributeMultiprocessorCount, dev) != hipSuccess) { grid = -1; return; }
        if (hipFuncSetAttribute((const void*)fwd_kernel, hipFuncAttributeMaxDynamicSharedMemorySize, LDS_BYTES) != hipSuccess) { grid = -1; return; }
        if (hipOccupancyMaxActiveBlocksPerMultiprocessor(&per_cu, (const void*)fwd_kernel, 512, LDS_BYTES) != hipSuccess || per_cu < 1)
            fprintf(stderr, "kernel_launch: occupancy query reports %d workgroups per CU\n", per_cu);
        (void)hipGetLastError();
        grid = cus;
        if (grid != 256) fprintf(stderr, "kernel_launch: %d CUs (the unit maps assume 256)\n", grid);
    }
    if (grid < 0) return;
    (void)hipMemsetAsync((char*)d_ws + WS_CTL, 0, CTL_ZERO_BYTES, stream);
    Args a{};
    for (int i = 0; i < N_INPUTS; ++i) a.in[i] = (const float*)d_in[i];
    a.out = (float*)d_out; a.ws = (unsigned char*)d_ws;
#if MK_PER_PHASE
    for (int p = 0; p <= N_PHASES; ++p) { a.ph_lo = p; a.ph_hi = p + 1; hipLaunchKernelGGL(fwd_kernel, dim3(grid), dim3(512), LDS_BYTES, stream, a); }
#else
#if PROBE_K > 0
    a.ph_lo = 0; a.ph_hi = PROBE_K;
    hipLaunchKernelGGL(fwd_kernel, dim3(grid), dim3(512), LDS_BYTES, stream, a);
    (void)hipMemsetAsync((char*)d_ws + WS_CTL, 0, CTL_ZERO_BYTES, stream);
#endif
    a.ph_lo = 0; a.ph_hi = N_PHASES + 1;
    hipLaunchKernelGGL(fwd_kernel, dim3(grid), dim3(512), LDS_BYTES, stream, a);
#endif
}
```
